# Optimizing an MI355X kernel written in HIP

```python
import math
import jax
import jax.numpy as jnp
from jax import lax
import numpy as np

D_MODEL = 4096
BATCH = 1
SEQ = 8192
DEPTH = 4

CTX_LEN = 256
GRID_W = 64
N_MIXERS = 3
EPS = 1e-6
F32 = jnp.float32

MLA_HEADS = D_MODEL // 128
MLA_Q_RANK = D_MODEL // 4
MLA_KV_RANK = 512
MLA_NOPE = 128
MLA_ROPE = 64
MLA_V = 128
MLA_WIDTH = MLA_HEADS * MLA_V
MLA_SPLITS = (MLA_Q_RANK, MLA_Q_RANK + MLA_KV_RANK, MLA_Q_RANK + MLA_KV_RANK + MLA_ROPE)
MLA_IN = MLA_SPLITS[2] + MLA_WIDTH
MLA_SCALE = (MLA_NOPE + MLA_ROPE) ** -0.5
ROPE_BASE = 10000.0
Q_BLOCK = 128

GDN_K_HEADS = D_MODEL // 128
GDN_V_HEADS = 2 * GDN_K_HEADS
GDN_DK = 128
GDN_DV = 128
GDN_KW = GDN_K_HEADS * GDN_DK
GDN_VW = GDN_V_HEADS * GDN_DV
GDN_QKV = 2 * GDN_KW + GDN_VW
GDN_IN = GDN_QKV + 4 * GDN_V_HEADS + GDN_VW
GDN_CONV = 5
GDN_CHUNK = 64

POOL_WINDOWS = (2, 4, 8, 16)
POOL_WIDTH = D_MODEL
POOL_GROUP = POOL_WIDTH // len(POOL_WINDOWS)

kernel_name = 'hybrid_mla_gdn_pool_prefix_dit'


def rms_norm(x, g):
    xf = x.astype(F32)
    y = xf * lax.rsqrt(jnp.mean(xf * xf, axis=-1, keepdims=True) + EPS)
    return (y * g.astype(F32)).astype(x.dtype)


def adaln(cond, w, b):
    m = (jax.nn.silu(cond) @ w + b)[:, None, :]
    return jnp.split(m, 3, axis=-1)


def axial_rope(rows):
    row = jnp.repeat(jnp.arange(rows, dtype=F32), GRID_W)
    col = jnp.tile(jnp.arange(GRID_W, dtype=F32), rows)
    n_freq = MLA_ROPE // 4
    inv_freq = ROPE_BASE ** (-jnp.arange(n_freq, dtype=F32) / n_freq)
    ang = jnp.concatenate([row[:, None] * inv_freq, col[:, None] * inv_freq], axis=-1)
    return jnp.cos(ang), jnp.sin(ang)


def apply_rope(x, cos, sin):
    x1, x2 = jnp.split(x, 2, axis=-1)
    return jnp.concatenate([x1 * cos - x2 * sin, x1 * sin + x2 * cos], axis=-1).astype(x.dtype)


def mla_queries(cq, g_q, w_q_up):
    B, L, _ = cq.shape
    q = (rms_norm(cq, g_q) @ w_q_up).reshape(B, L, MLA_HEADS, MLA_NOPE + MLA_ROPE)
    return q[..., :MLA_NOPE], q[..., MLA_NOPE:]


def mla_keys_values(ckv, g_kv, w_kv_up):
    B, L, _ = ckv.shape
    kv = (rms_norm(ckv, g_kv) @ w_kv_up).reshape(B, L, MLA_HEADS, MLA_NOPE + MLA_V)
    return kv[..., :MLA_NOPE], kv[..., MLA_NOPE:]


def mla_attend(qn, qr, kn, kr, v):
    s = (jnp.einsum('bqhd,bkhd->bhqk', qn, kn).astype(F32)
         + jnp.einsum('bqhr,bkr->bhqk', qr, kr).astype(F32))
    p = jax.nn.softmax(s * MLA_SCALE, axis=-1)
    return jnp.einsum('bhqk,bkhd->bqhd', p.astype(v.dtype), v)


def mla_mixer(h_lat, h_ctx, cos, sin, w_in, g_q, w_q_up, g_kv, w_kv_up, w_out, need_ctx_out):
    B, S, _ = h_lat.shape
    C = h_ctx.shape[1]
    cq_l, ckv_l, kr_l, z_l = jnp.split(h_lat @ w_in, MLA_SPLITS, axis=-1)
    qn_l, qr_l = mla_queries(cq_l, g_q, w_q_up)
    qr_l = apply_rope(qr_l, cos[None, :, None, :], sin[None, :, None, :])
    kr_l = apply_rope(kr_l, cos[None], sin[None])
    kn_l, v_l = mla_keys_values(ckv_l, g_kv, w_kv_up)
    if need_ctx_out:
        cq_c, ckv_c, kr_c, z_c = jnp.split(h_ctx @ w_in, MLA_SPLITS, axis=-1)
    else:
        ckv_c, kr_c = jnp.split(h_ctx @ w_in[:, MLA_Q_RANK:MLA_SPLITS[2]], [MLA_KV_RANK], axis=-1)
    kn_c, v_c = mla_keys_values(ckv_c, g_kv, w_kv_up)
    kn_all = jnp.concatenate([kn_c, kn_l], axis=1)
    kr_all = jnp.concatenate([kr_c, kr_l], axis=1)
    v_all = jnp.concatenate([v_c, v_l], axis=1)
    nb = S // Q_BLOCK

    def to_blocks(t):
        return jnp.moveaxis(t.reshape(B, nb, Q_BLOCK, *t.shape[2:]), 1, 0)

    o_l = lax.map(lambda qb: mla_attend(qb[0], qb[1], kn_all, kr_all, v_all),
                  (to_blocks(qn_l), to_blocks(qr_l)))
    o_l = jnp.moveaxis(o_l, 0, 1).reshape(B, S, MLA_WIDTH)
    y_lat = (o_l * jax.nn.silu(z_l)) @ w_out
    y_ctx = None
    if need_ctx_out:
        qn_c, qr_c = mla_queries(cq_c, g_q, w_q_up)
        o_c = mla_attend(qn_c, qr_c, kn_c, kr_c, v_c).reshape(B, C, MLA_WIDTH)
        y_ctx = (o_c * jax.nn.silu(z_c)) @ w_out
    return y_lat, y_ctx


def l2_normalize(t):
    t = t.astype(F32)
    return t * lax.rsqrt(jnp.sum(t * t, axis=-1, keepdims=True) + EPS)


def centred_depthwise_conv(u, w):
    L = u.shape[1]
    r = GDN_CONV // 2
    up = jnp.pad(u, ((0, 0), (r, r), (0, 0)))
    return sum(up[:, j:j + L] * w[j] for j in range(GDN_CONV))


def gdn_project(h, w_in, conv_w):
    B, L, _ = h.shape
    qkv, a, b, z = jnp.split(h @ w_in, [GDN_QKV, GDN_QKV + 2 * GDN_V_HEADS, GDN_QKV + 4 * GDN_V_HEADS], axis=-1)
    qkv = jax.nn.silu(centred_depthwise_conv(qkv, conv_w))
    q, k, v = jnp.split(qkv, [GDN_KW, 2 * GDN_KW], axis=-1)
    rep = GDN_V_HEADS // GDN_K_HEADS
    q = jnp.repeat(l2_normalize(q.reshape(B, L, GDN_K_HEADS, GDN_DK)), rep, axis=2) * (GDN_DK ** -0.5)
    k = jnp.repeat(l2_normalize(k.reshape(B, L, GDN_K_HEADS, GDN_DK)), rep, axis=2)
    v = v.reshape(B, L, GDN_V_HEADS, GDN_DV).astype(F32)
    a = a.reshape(B, L, 2, GDN_V_HEADS).astype(F32)
    b = b.reshape(B, L, 2, GDN_V_HEADS).astype(F32)
    z = z.reshape(B, L, GDN_V_HEADS, GDN_DV)
    return q, k, v, a, b, z


def gdn_gates(a, b, a_log, dt_bias, d):
    g = -jnp.exp(a_log[d].astype(F32)) * jax.nn.softplus(a[:, :, d] + dt_bias[d].astype(F32))
    beta = jax.nn.sigmoid(b[:, :, d])
    return g, beta


def gated_delta_chunked(q, k, v, g, beta, state0):
    B, L, H, _ = k.shape
    n, C = L // GDN_CHUNK, GDN_CHUNK

    def chunks(t):
        t = t.astype(F32).reshape(B, n, C, H, *t.shape[3:])
        return jnp.moveaxis(t, 3, 1)

    q, k, v, g, beta = (chunks(t) for t in (q, k, v, g, beta))
    g = jnp.cumsum(g, axis=-1)
    lower = jnp.tril(jnp.ones((C, C), dtype=bool))
    strict = jnp.tril(jnp.ones((C, C), dtype=bool), -1)
    decay = jnp.exp(jnp.where(lower, g[..., :, None] - g[..., None, :], -jnp.inf))
    k_beta = k * beta[..., None]
    a = jnp.where(strict, jnp.einsum('bhncd,bhnsd->bhncs', k_beta, k) * decay, 0.0)
    eye = jnp.eye(C, dtype=F32)
    t_inv = lax.linalg.triangular_solve(a + eye, jnp.broadcast_to(eye, a.shape),
                                        left_side=True, lower=True, unit_diagonal=True)
    u = t_inv @ (v * beta[..., None])
    w = t_inv @ (k_beta * jnp.exp(g)[..., None])
    qk = jnp.where(lower, jnp.einsum('bhncd,bhnsd->bhncs', q, k) * decay, 0.0)
    q_dec = q * jnp.exp(g)[..., None]
    k_dec = k * jnp.exp(g[..., -1:] - g)[..., None]
    g_last = jnp.exp(g[..., -1])

    def step(state, xs):
        qk_i, q_i, k_i, u_i, w_i, gl_i = xs
        v_new = u_i - jnp.einsum('bhcd,bhde->bhce', w_i, state)
        o_i = jnp.einsum('bhcd,bhde->bhce', q_i, state) + jnp.einsum('bhcs,bhse->bhce', qk_i, v_new)
        state = state * gl_i[..., None, None] + jnp.einsum('bhcd,bhce->bhde', k_i, v_new)
        return state, o_i

    xs = tuple(jnp.moveaxis(t, 2, 0) for t in (qk, q_dec, k_dec, u, w, g_last))
    state, o = lax.scan(step, state0, xs)
    o = o.transpose(1, 0, 3, 2, 4).reshape(B, L, H, -1)
    return o, state


def gdn_output(o, z, g_norm, w_out):
    B, L = o.shape[:2]
    y = rms_norm(o, g_norm) * jax.nn.silu(z.astype(F32))
    return y.reshape(B, L, GDN_VW).astype(z.dtype) @ w_out


def gdn_mixer(h_lat, h_ctx, w_in, conv_w, a_log, dt_bias, g_norm, w_out, need_ctx_out):
    q_l, k_l, v_l, a_l, b_l, z_l = gdn_project(h_lat, w_in, conv_w)
    q_c, k_c, v_c, a_c, b_c, z_c = gdn_project(h_ctx, w_in, conv_w)
    state0 = jnp.zeros((h_ctx.shape[0], GDN_V_HEADS, GDN_DK, GDN_DV), F32)
    o_lat, o_ctx = [], []
    for d in range(2):
        def dirn(t, flip=(d == 1)):
            return jnp.flip(t, axis=1) if flip else t
        g_c, beta_c = gdn_gates(a_c, b_c, a_log, dt_bias, d)
        oc, s_ctx = gated_delta_chunked(dirn(q_c), dirn(k_c), dirn(v_c), dirn(g_c), dirn(beta_c), state0)
        g_l, beta_l = gdn_gates(a_l, b_l, a_log, dt_bias, d)
        ol, _ = gated_delta_chunked(dirn(q_l), dirn(k_l), dirn(v_l), dirn(g_l), dirn(beta_l), s_ctx)
        o_lat.append(dirn(ol))
        o_ctx.append(dirn(oc))
    y_lat = gdn_output(o_lat[0] + o_lat[1], z_l, g_norm, w_out)
    y_ctx = gdn_output(o_ctx[0] + o_ctx[1], z_c, g_norm, w_out) if need_ctx_out else None
    return y_lat, y_ctx


def window_mean_minus_self(u, radius):
    B, L, G = u.shape
    csum = jnp.concatenate([jnp.zeros((B, 1, G), u.dtype), jnp.cumsum(u, axis=1)], axis=1)
    t = jnp.arange(L)
    lo = jnp.maximum(t - radius, 0)
    hi = jnp.minimum(t + radius + 1, L)
    mean = (csum[:, hi] - csum[:, lo]) / (hi - lo).astype(u.dtype)[None, :, None]
    return mean - u


def pool_branch(h, w_in, w_grp, scale, w_out):
    B, L, _ = h.shape
    u, z = jnp.split(h @ w_in, 2, axis=-1)
    groups = jnp.split(u.astype(F32), len(POOL_WINDOWS), axis=-1)
    m = jnp.stack([window_mean_minus_self(gu, w // 2) for gu, w in zip(groups, POOL_WINDOWS)],
                  axis=2).astype(h.dtype)
    y = jnp.einsum('blgc,gcd->blgd', m, w_grp).reshape(B, L, POOL_WIDTH) * scale
    return (y * jax.nn.silu(z)) @ w_out


def pool_mixer(h_lat, h_ctx, w_in, w_grp, scale, w_out, need_ctx_out):
    y_lat = pool_branch(h_lat, w_in, w_grp, scale, w_out)
    y_ctx = pool_branch(h_ctx, w_in, w_grp, scale, w_out) if need_ctx_out else None
    return y_lat, y_ctx


def setup_inputs(seed: int = 0) -> dict:
    key = jax.random.key(seed)
    ks = iter(jax.random.split(key, 40))

    def normal(shape, scale):
        return jax.random.normal(next(ks), shape, F32) * scale

    def gain(shape):
        return 1.0 + 0.1 * jax.random.normal(next(ks), shape, F32)

    n_mla = len([i for i in range(DEPTH) if i % N_MIXERS == 0])
    n_gdn = len([i for i in range(DEPTH) if i % N_MIXERS == 1])
    n_pool = len([i for i in range(DEPTH) if i % N_MIXERS == 2])
    a_decay = jax.random.uniform(next(ks), (n_gdn, 2, GDN_V_HEADS), F32, 1.0, 16.0)
    dt = jnp.exp(jax.random.uniform(next(ks), (n_gdn, 2, GDN_V_HEADS), F32,
                                    math.log(1e-3), math.log(1e-1)))
    return {
        'x': normal((BATCH, SEQ, D_MODEL), 1.0),
        'c': normal((BATCH, D_MODEL), 1.0),
        'ctx': normal((BATCH, CTX_LEN, D_MODEL), 1.0),
        'c_ctx': normal((D_MODEL,), 1.0),
        'ada_w': normal((DEPTH, D_MODEL, 3 * D_MODEL), D_MODEL ** -0.5),
        'ada_b': normal((DEPTH, 3 * D_MODEL), 0.02),
        'norm_pre': gain((DEPTH, D_MODEL)),
        'norm_post': gain((DEPTH, D_MODEL)),
        'mla_w_in': normal((n_mla, D_MODEL, MLA_IN), D_MODEL ** -0.5),
        'mla_g_q': gain((n_mla, MLA_Q_RANK)),
        'mla_w_q_up': normal((n_mla, MLA_Q_RANK, MLA_HEADS * (MLA_NOPE + MLA_ROPE)), MLA_Q_RANK ** -0.5),
        'mla_g_kv': gain((n_mla, MLA_KV_RANK)),
        'mla_w_kv_up': normal((n_mla, MLA_KV_RANK, MLA_HEADS * (MLA_NOPE + MLA_V)), MLA_KV_RANK ** -0.5),
        'mla_w_out': normal((n_mla, MLA_WIDTH, D_MODEL), MLA_WIDTH ** -0.5),
        'gdn_w_in': normal((n_gdn, D_MODEL, GDN_IN), D_MODEL ** -0.5),
        'gdn_conv_w': normal((n_gdn, GDN_CONV, GDN_QKV), GDN_CONV ** -0.5),
        'gdn_a_log': jnp.log(a_decay),
        'gdn_dt_bias': dt + jnp.log(-jnp.expm1(-dt)),
        'gdn_g_norm': gain((n_gdn, GDN_DV)),
        'gdn_w_out': normal((n_gdn, GDN_VW, D_MODEL), GDN_VW ** -0.5),
        'pool_w_in': normal((n_pool, D_MODEL, 2 * POOL_WIDTH), D_MODEL ** -0.5),
        'pool_w_grp': normal((n_pool, len(POOL_WINDOWS), POOL_GROUP, POOL_GROUP), POOL_GROUP ** -0.5),
        'pool_scale': gain((n_pool, POOL_WIDTH)),
        'pool_w_out': normal((n_pool, POOL_WIDTH, D_MODEL), POOL_WIDTH ** -0.5),
    }


def reference(x, c, ctx, c_ctx, ada_w, ada_b, norm_pre, norm_post,
              mla_w_in, mla_g_q, mla_w_q_up, mla_g_kv, mla_w_kv_up, mla_w_out,
              gdn_w_in, gdn_conv_w, gdn_a_log, gdn_dt_bias, gdn_g_norm, gdn_w_out,
              pool_w_in, pool_w_grp, pool_scale, pool_w_out):
    ROWS = x.shape[1] // GRID_W
    cos, sin = axial_rope(ROWS)
    xc = ctx
    counts = [0, 0, 0]
    for i in range(DEPTH):
        kind = i % N_MIXERS
        j = counts[kind]
        counts[kind] += 1
        need_ctx = i < DEPTH - 1
        sh_l, sc_l, gt_l = adaln(c, ada_w[i], ada_b[i])
        sh_c, sc_c, gt_c = adaln(c_ctx[None], ada_w[i], ada_b[i])
        h_l = rms_norm(x, norm_pre[i]) * (1 + sc_l) + sh_l
        h_c = rms_norm(xc, norm_pre[i]) * (1 + sc_c) + sh_c
        if kind == 0:
            y_l, y_c = mla_mixer(h_l, h_c, cos, sin, mla_w_in[j], mla_g_q[j], mla_w_q_up[j],
                                 mla_g_kv[j], mla_w_kv_up[j], mla_w_out[j], need_ctx)
        elif kind == 1:
            y_l, y_c = gdn_mixer(h_l, h_c, gdn_w_in[j], gdn_conv_w[j], gdn_a_log[j], gdn_dt_bias[j],
                                 gdn_g_norm[j], gdn_w_out[j], need_ctx)
        else:
            y_l, y_c = pool_mixer(h_l, h_c, pool_w_in[j], pool_w_grp[j], pool_scale[j], pool_w_out[j], need_ctx)
        x = x + gt_l * rms_norm(y_l, norm_post[i])
        if need_ctx:
            xc = xc + gt_c * rms_norm(y_c, norm_post[i])
    return x
```

```cpp
#include <hip/hip_runtime.h>
#include <stdint.h>
#include <stdio.h>

#ifndef N_LAUNCHES
#define N_LAUNCHES 1
#endif

typedef unsigned short bf16_t;
typedef short bf16x8 __attribute__((ext_vector_type(8)));
typedef short s16x4 __attribute__((ext_vector_type(4)));
typedef float f32x2 __attribute__((ext_vector_type(2)));
typedef float f32x4 __attribute__((ext_vector_type(4)));
typedef float f32x16 __attribute__((ext_vector_type(16)));
typedef unsigned u32x2 __attribute__((ext_vector_type(2)));
typedef unsigned u32x4 __attribute__((ext_vector_type(4)));
#define LAS __attribute__((address_space(3)))

constexpr int TR = 8448;
constexpr int NCTX = 256, NLAT = 8192, DM = 4096;
constexpr float EPS = 1e-6f;
constexpr int MLA_NP = 5888;
constexpr int GDN_IN = 24832;

constexpr size_t al256(size_t x) { return (x + 255) & ~(size_t)255; }
constexpr size_t WS_BAR = 0;
constexpr size_t WS_MOD = 16384;
constexpr size_t WS_ROPE = WS_MOD + al256(4 * 2 * 12288 * 4);
constexpr size_t WS_XC = WS_ROPE + al256((size_t)8192 * 64 * 4);
constexpr size_t WS_H = WS_XC + al256((size_t)256 * 4096 * 4);
constexpr size_t WS_Y = WS_H + al256((size_t)TR * 4096 * 2);
constexpr size_t WS_W_MLA_IN = WS_Y + al256((size_t)TR * 4096 * 4);
constexpr size_t SZ_W_MLA_IN = (size_t)MLA_NP * 4096 * 2;
constexpr size_t WS_W_QUP = WS_W_MLA_IN + 2 * SZ_W_MLA_IN;
constexpr size_t SZ_W_QUP = (size_t)6144 * 1024 * 2;
constexpr size_t WS_W_KVUP = WS_W_QUP + 2 * SZ_W_QUP;
constexpr size_t SZ_W_KVUP = (size_t)8192 * 512 * 2;
constexpr size_t WS_W_MLA_OUT = WS_W_KVUP + 2 * SZ_W_KVUP;
constexpr size_t SZ_W_MLA_OUT = (size_t)4096 * 4096 * 2;
constexpr size_t WS_W_GDN_IN = WS_W_MLA_OUT + 2 * SZ_W_MLA_OUT;
constexpr size_t WS_W_GDN_OUT = WS_W_GDN_IN + (size_t)GDN_IN * 4096 * 2;
constexpr size_t WS_W_POOL_IN = WS_W_GDN_OUT + (size_t)4096 * 8192 * 2;
constexpr size_t WS_W_POOL_GRP = WS_W_POOL_IN + (size_t)8192 * 4096 * 2;
constexpr size_t WS_W_POOL_OUT = WS_W_POOL_GRP + (size_t)4096 * 1024 * 2;
constexpr size_t WS_ACT = WS_W_POOL_OUT + (size_t)4096 * 4096 * 2;
constexpr size_t A_CQ = WS_ACT;
constexpr size_t A_CKV = A_CQ + (size_t)TR * 1024 * 2;
constexpr size_t A_Z = A_CKV + (size_t)TR * 512 * 2;
constexpr size_t A_KRRAW = A_Z + (size_t)TR * 4096 * 2;
constexpr size_t A_KR = A_KRRAW + (size_t)TR * 256 * 4;
constexpr size_t A_RSQ = A_KR + (size_t)TR * 64 * 2;
constexpr size_t A_RSKV = A_RSQ + al256((size_t)TR * 4);
constexpr size_t A_Q = A_RSKV + al256((size_t)TR * 4);
constexpr size_t A_KV = A_Q + (size_t)TR * 6144 * 2;
constexpr size_t A_OG = A_KV + (size_t)TR * 8192 * 2;
constexpr size_t A_MLA_END = A_OG + (size_t)TR * 4096 * 2;
constexpr size_t G_QKV = WS_ACT;
constexpr size_t G_AB = G_QKV + (size_t)TR * 16384 * 2;
constexpr size_t G_Z = G_AB + (size_t)TR * 256 * 4;
constexpr size_t G_QR = G_Z + (size_t)TR * 8192 * 2;
constexpr size_t G_KR = G_QR + (size_t)TR * 4096 * 2;
constexpr size_t G_KT = G_KR + (size_t)TR * 4096 * 2;
constexpr size_t G_VT = G_KT + (size_t)TR * 4096 * 2;
constexpr size_t G_GATE = G_VT + (size_t)TR * 8192 * 2;
constexpr size_t G_O = G_GATE + (size_t)2 * TR * 64 * 2 * 4;
constexpr size_t G_OG = G_O + (size_t)2 * TR * 8192 * 2;
constexpr size_t G_BLOBA = G_OG + (size_t)TR * 8192 * 2;
constexpr size_t BLOBA_SZ = 32768;
constexpr size_t G_BLOBB = G_BLOBA + (size_t)132 * 32 * BLOBA_SZ;
constexpr size_t BLOBB_SZ = 25600;
constexpr size_t G_UF = G_QR;
constexpr size_t UF_SZ = 16384;
constexpr size_t G_END = G_BLOBB + (size_t)132 * 128 * BLOBB_SZ;
constexpr size_t P_U = WS_ACT;
constexpr size_t P_Z = P_U + (size_t)TR * 4096 * 4;
constexpr size_t P_M = P_Z + (size_t)TR * 4096 * 2;
constexpr size_t P_G = P_M + (size_t)TR * 4096 * 2;
constexpr size_t WS_YPART = G_END > A_MLA_END ? G_END : A_MLA_END;
constexpr int YPARTS = 16;
constexpr size_t WS_XB = WS_YPART + (size_t)YPARTS * 256 * 4096 * 4;
constexpr size_t WS_END = WS_XB + (size_t)8192 * 4096 * 2;

constexpr int LDS_STAGE = 131072;
constexpr int LDS_BYTES = LDS_STAGE + 256;
constexpr int ROWS_PRM = 1024;

typedef __bf16 bf16x2v __attribute__((ext_vector_type(2)));
__device__ __forceinline__ unsigned cvt_pk_bf16(float lo, float hi) { const f32x2 v = {lo, hi}; return __builtin_bit_cast(unsigned, __builtin_convertvector(v, bf16x2v)); }
__device__ __forceinline__ float bf_lo(unsigned w) { return __uint_as_float(w << 16); }
__device__ __forceinline__ float bf_hi(unsigned w) { return __uint_as_float(w & 0xffff0000u); }
__device__ __forceinline__ float bf2f(bf16_t b) { return __uint_as_float(((unsigned)b) << 16); }
__device__ __forceinline__ bf16_t f2bf(float f) { return (bf16_t)(cvt_pk_bf16(f, 0.f) & 0xffffu); }
__device__ __forceinline__ float silu_f(float z) { return z * __builtin_amdgcn_rcpf(1.f + __expf(-z)); }
__device__ __forceinline__ int lane_opaque() { int l; asm volatile("v_mbcnt_lo_u32_b32 %0, -1, 0\n\tv_mbcnt_hi_u32_b32 %0, -1, %0" : "=v"(l)); return l; }
__device__ __forceinline__ int tid_opaque(int wave) { return wave * 64 + lane_opaque(); }
__device__ __forceinline__ float wave_sum(float v) {
#pragma unroll
    for (int o = 32; o >= 1; o >>= 1) v += __shfl_xor(v, o);
    return v;
}

#define XB_TMO      128
#define XB_XCNT(j)  (256  + 64 * (j))
#define XB_XSUB(j)  (1280 + 64 * (j))
#define XB_XGEN(j)  (2304 + 64 * (j))
#define XB_TOP      3328
#define XB_TOPGEN   3392
#define XCD_BAR_WORDS 3456
#define XB_SPIN_CAP (1u << 22)

__device__ __forceinline__ unsigned xb_ld(unsigned* p)              { return __hip_atomic_load(p, __ATOMIC_RELAXED, __HIP_MEMORY_SCOPE_AGENT); }
__device__ __forceinline__ unsigned xb_add(unsigned* p, unsigned v) { return __hip_atomic_fetch_add(p, v, __ATOMIC_RELAXED, __HIP_MEMORY_SCOPE_AGENT); }
__device__ __forceinline__ unsigned xb_xcc_id() { return (unsigned)__builtin_amdgcn_s_getreg((3 << 11) | 20) & 0xFu; }
#define XB_SPIN(cond, bar) do { unsigned _sp = 0; while (cond) { __builtin_amdgcn_s_sleep(1); \
    if ((++_sp & 255u) == 0u) { if (xb_ld(&(bar)[XB_TMO])) break; if (_sp > XB_SPIN_CAP) { atomicAdd(&(bar)[XB_TMO], 1u); break; } } } } while (0)

struct XcdBarrier { unsigned* bar; unsigned x; volatile LAS unsigned* st; unsigned w; };
__device__ __forceinline__ bool xb_thread0(unsigned w) { return w == 0u && lane_opaque() == 0; }

__device__ __forceinline__ XcdBarrier xcd_barrier_post(unsigned* bar, volatile LAS unsigned* st, unsigned w) {
    XcdBarrier b; b.bar = bar; b.x = xb_xcc_id(); b.st = st; b.w = w;
    if (xb_thread0(w)) (void)xb_add(&bar[XB_XCNT(b.x)], 1u);
    return b;
}
__device__ __forceinline__ void xcd_barrier_complete(unsigned* bar, unsigned x, unsigned& nloc, unsigned& nx) {
    const unsigned G = gridDim.x * gridDim.y * gridDim.z;
    unsigned sum, cnt, mine, sp = 0u;
    for (;;) {
        sum = 0u; cnt = 0u; mine = 0u;
#pragma unroll
        for (unsigned j = 0; j < 16; ++j) { const unsigned c = xb_ld(&bar[XB_XCNT(j)]); sum += c; cnt += (c > 0u) ? 1u : 0u; mine = (j == x) ? c : mine; }
        if (sum == G) break;
        __builtin_amdgcn_s_sleep(1);
        if ((++sp & 255u) == 0u) { if (xb_ld(&bar[XB_TMO])) break; if (sp > XB_SPIN_CAP) { atomicAdd(&bar[XB_TMO], 1u); break; } }
    }
    nloc = mine > 0u ? mine : 1u; nx = cnt > 0u ? cnt : 1u;
}
__device__ __forceinline__ void xcd_barrier(const XcdBarrier& b) {
    asm volatile("s_waitcnt vmcnt(0)" ::: "memory");
    __syncthreads();
    if (xb_thread0(b.w)) {
        unsigned* bar = b.bar;
        __builtin_amdgcn_s_waitcnt(0);
        unsigned nloc = b.st[0], nx = b.st[1];
        if (nloc == 0u) { xcd_barrier_complete(bar, b.x, nloc, nx); b.st[0] = nloc; b.st[1] = nx; }
        const unsigned old = xb_add(&bar[XB_XSUB(b.x)], 1u);
        const unsigned gen = old / nloc;
        if (old + 1u == (gen + 1u) * nloc) {
            __builtin_amdgcn_fence(__ATOMIC_RELEASE, "agent");
            asm volatile("s_waitcnt vmcnt(0)" ::: "memory");
            const unsigned og = xb_add(&bar[XB_TOP], 1u);
            const unsigned tg = og / nx;
            if (og + 1u == (tg + 1u) * nx) xb_add(&bar[XB_TOPGEN], 1u);
            else XB_SPIN(xb_ld(&bar[XB_TOPGEN]) == tg, bar);
            __builtin_amdgcn_fence(__ATOMIC_ACQUIRE, "agent");
            xb_add(&bar[XB_XGEN(b.x)], 1u);
            asm volatile("s_waitcnt vmcnt(0)" ::: "memory");
        } else {
            XB_SPIN(xb_ld(&bar[XB_XGEN(b.x)]) == gen, bar);
            __builtin_amdgcn_fence(__ATOMIC_ACQUIRE, "agent");
            asm volatile("s_waitcnt vmcnt(0)" ::: "memory");
        }
    }
    __syncthreads();
}

namespace pg8 {
constexpr int BM = 256, BK = 64, HALF = 128, HTB = HALF * BK * 2, STAGE_BYTES = 8 * HTB, NXCD = 8, WGM = 8;
__host__ __device__ __forceinline__ int lds_byte(int r, int c) { const int st = (r >> 4) * 2 + (c >> 5), rr = r & 15, cc = c & 31, ob = rr * 64 + cc * 2; return st * 1024 + (ob ^ (((ob >> 9) & 1) << 5)); }
__host__ __device__ __forceinline__ void stage_rc(int b, int& R, int& C) { const int st = b / 1024, sb = b % 1024, swz = sb ^ (((sb >> 9) & 1) << 5); R = (st >> 1) * 16 + swz / 64; C = (st & 1) * 32 + (swz % 64) / 2; }
__host__ __device__ __forceinline__ int perm32(int rho) { const int n = rho >> 4, i = rho & 15; return 8 * (i >> 2) + 4 * n + (i & 3); }

struct Unit { int pm, pn; };
template <size_t A_OFF_, size_t B_OFF_, int N_, int K_, int LDA_, int LDB_, int GRP_, int MT0_ = 0, int MT_ = TR / 256 - MT0_, int SPLIT_ = 0, int ORD_ = 0>
struct GC { static constexpr size_t A_OFF = A_OFF_, B_OFF = B_OFF_; static constexpr int N = N_, K = K_, LDA = LDA_, LDB = LDB_, GRP = GRP_, MT0 = MT0_, MT = MT_, SPLIT = SPLIT_, ORD = ORD_; };

template <int nM, int nN>
__device__ __forceinline__ bool next_unit(int i, int G, int c, Unit& u) {
    constexpr int nwg = nM * nN;
    const int L = i * G + c; if (L >= nwg) return false;
    int wgid = L; { constexpr int q = nwg / NXCD, r = nwg % NXCD; const int xcd = wgid % NXCD, off = wgid / NXCD; wgid = (xcd < r ? xcd * (q + 1) : r * (q + 1) + (xcd - r) * q) + off; }
    constexpr int nig = WGM * nN; const int gid = wgid / nig, fm = gid * WGM, gsz = (nM - fm) < WGM ? (nM - fm) : WGM;
    u.pm = fm + ((wgid % nig) % gsz); u.pn = (wgid % nig) / gsz; return true;
}

template <int nM, int nN>
__device__ __forceinline__ bool next_unit_sweep(int i, int G, int c, Unit& u) {
    constexpr int nwg = nM * nN, PM = nM / NXCD, R = nM % NXCD, mainc = PM * nN;
    const int L = i * G + c; if (L >= nwg) return false;
    const int xcd = L % NXCD, off = L / NXCD;
    if (off < mainc) { u.pn = off / PM; u.pm = R + xcd * PM + off % PM; }
    else { const int t = xcd + NXCD * (off - mainc); u.pm = t / nN; u.pn = t % nN; }
    return true;
}
template <class G_, int nM, int nN>
__device__ __forceinline__ bool next_unit_sel(int i, int G, int c, Unit& u) {
    if (G_::ORD == 1) return next_unit_sweep<nM, nN>(i, G, c, u);
    return next_unit<nM, nN>(i, G, c, u);
}

template <class G_, class Epi>
__device__ __forceinline__ void gemm_phase(LAS unsigned char* lds, unsigned char* ws, int G, int c, const Epi& E, int wave) {
    const int tid = tid_opaque(wave), wid = wave, lane = tid & 63, wr = wid >> 2, wc = wid & 3, fr = lane & 15, fq = lane >> 4;
    constexpr int SP = G_::SPLIT > 0 ? G_::SPLIT : 1, K = G_::K / SP, nt = K / BK, nM = G_::MT, nN = (G_::N / BM) * SP;
    static_assert(K >= 256 && K % 128 == 0, "K per unit");
    unsigned voffA[2], voffB[2];
#pragma unroll
    for (int i = 0; i < 2; ++i) { int R, C; stage_rc(tid * 16 + i * 8192, R, C); const int Rb = (R & ~31) + perm32(R & 31);
        voffA[i] = (unsigned)(R * G_::LDA + C) * 2u; voffB[i] = (unsigned)(Rb * G_::LDB + C) * 2u; }
    constexpr unsigned kstep = BK * 2;
    constexpr unsigned hstepA = HALF * G_::LDA * 2, hstepB = HALF * G_::LDB * 2;
    constexpr unsigned tstepA = 2 * hstepA, tstepB = 2 * hstepB;
    const unsigned ldsw = (unsigned)wid * 1024u;
    const int aoff = lds_byte(wr * 64 + fr, fq * 8), boff = lds_byte(wc * 32 + fr, fq * 8);
    const char* const Abase = (const char*)(ws + G_::A_OFF); const char* const Bbase = (const char*)(ws + G_::B_OFF);
#define PG8_SA(b, h) (((b) * 2 + (h)) * HTB)
#define PG8_SB(b, h) ((4 + (b) * 2 + (h)) * HTB)
#define PG8_STAGE(bufoff, gbase, goff, voff) do { _Pragma("unroll") for (int _i = 0; _i < 2; ++_i) \
        __builtin_amdgcn_global_load_lds((const unsigned*)((gbase) + (size_t)((goff) + (voff)[_i])), (LAS unsigned*)(lds + (bufoff) + ldsw + _i * 8192), 16, 0, 0); } while (0)
#define PG8_LDA(dst, b, h) do { _Pragma("unroll") for (int m = 0; m < 4; ++m) _Pragma("unroll") for (int k = 0; k < 2; ++k) dst[m][k] = *(const LAS bf16x8*)(lds + PG8_SA(b, h) + aoff + m * 2048 + k * 1024); } while (0)
#define PG8_LDB(dst, b, h) do { _Pragma("unroll") for (int n = 0; n < 2; ++n) _Pragma("unroll") for (int k = 0; k < 2; ++k) dst[n][k] = *(const LAS bf16x8*)(lds + PG8_SB(b, h) + boff + n * 2048 + k * 1024); } while (0)
#define PG8_MMA(ai, bj, At, Bt) do { __builtin_amdgcn_s_setprio(1); _Pragma("unroll") for (int m = 0; m < 4; ++m) _Pragma("unroll") for (int n = 0; n < 2; ++n) _Pragma("unroll") for (int k = 0; k < 2; ++k) \
        acc[ai][bj][m][n] = __builtin_amdgcn_mfma_f32_16x16x32_bf16(Bt[n][k], At[m][k], acc[ai][bj][m][n], 0, 0, 0); __builtin_amdgcn_s_setprio(0); } while (0)
#define PG8_WAIT_V(n) asm volatile("s_waitcnt vmcnt(" #n ")" ::: "memory")
#define PG8_WAIT_L(n) asm volatile("s_waitcnt lgkmcnt(" #n ")" ::: "memory")
#define PG8_BAR __builtin_amdgcn_s_barrier()
#define PG8_SCHED __builtin_amdgcn_sched_barrier(0)
#define PG8_AOFF(u) ((unsigned)(u).pm * tstepA + (G_::GRP ? (unsigned)((u).pn / (G_::GRP ? G_::GRP : 1)) * (unsigned)(K * 2) : 0u) + (G_::SPLIT ? (unsigned)((u).pn % SP) * (unsigned)(K * 2) : 0u))
#define PG8_BOFF(u) ((unsigned)((u).pn / SP) * tstepB + (G_::SPLIT ? (unsigned)((u).pn % SP) * (unsigned)(K * 2) : 0u))
    Unit cur, nxt; int ui = 0;
    if (!next_unit_sel<G_, nM, nN>(0, G, c, cur)) return;
    cur.pm += G_::MT0;
    f32x4 acc[2][2][4][2];
#pragma unroll
    for (int a = 0; a < 2; ++a)
#pragma unroll
        for (int b = 0; b < 2; ++b)
#pragma unroll
            for (int m = 0; m < 4; ++m)
#pragma unroll
                for (int n = 0; n < 2; ++n) acc[a][b][m][n] = (f32x4){0.f, 0.f, 0.f, 0.f};
    bf16x8 At[4][2], B0[2][2], B1[2][2];
    unsigned cA = PG8_AOFF(cur), cB = PG8_BOFF(cur);
    PG8_STAGE(PG8_SB(0, 0), Bbase, cB, voffB); PG8_STAGE(PG8_SA(0, 0), Abase, cA, voffA); PG8_STAGE(PG8_SB(0, 1), Bbase, cB + hstepB, voffB); PG8_STAGE(PG8_SA(0, 1), Abase, cA + hstepA, voffA);
    if (wr == 1) PG8_BAR;
    PG8_WAIT_V(4); PG8_BAR;
    PG8_STAGE(PG8_SB(1, 0), Bbase, cB + kstep, voffB); PG8_STAGE(PG8_SA(1, 0), Abase, cA + kstep, voffA); PG8_STAGE(PG8_SB(1, 1), Bbase, cB + hstepB + kstep, voffB);
    PG8_WAIT_V(6); PG8_BAR;
    for (;;) {
        const bool has_next = next_unit_sel<G_, nM, nN>(ui + 1, G, c, nxt);
        nxt.pm += G_::MT0;
        const unsigned nA = has_next ? PG8_AOFF(nxt) : cA, nB = has_next ? PG8_BOFF(nxt) : cB;
        for (int t = 0; t < nt; t += 2) {
            const bool last = (t == nt - 2);
            const unsigned a1 = cA + (unsigned)(t + 1) * kstep;
            const unsigned a2 = last ? nA : cA + (unsigned)(t + 2) * kstep, b2 = last ? nB : cB + (unsigned)(t + 2) * kstep;
            const unsigned a3 = a2 + kstep, b3 = b2 + kstep;
            PG8_LDB(B0, 0, 0); PG8_SCHED; PG8_LDA(At, 0, 0); PG8_STAGE(PG8_SA(1, 1), Abase, a1 + hstepA, voffA);
            PG8_WAIT_L(8); PG8_BAR; PG8_WAIT_L(0); PG8_MMA(0, 0, At, B0); PG8_BAR; PG8_SCHED;
            PG8_LDB(B1, 0, 1); PG8_STAGE(PG8_SB(0, 0), Bbase, b2, voffB);
            PG8_BAR; PG8_WAIT_L(0); PG8_MMA(0, 1, At, B1); PG8_BAR;
            PG8_LDA(At, 0, 1); PG8_STAGE(PG8_SA(0, 0), Abase, a2, voffA);
            PG8_BAR; PG8_WAIT_L(0); PG8_MMA(1, 0, At, B0); PG8_BAR; PG8_SCHED;
            PG8_STAGE(PG8_SB(0, 1), Bbase, b2 + hstepB, voffB);
            PG8_WAIT_V(6); PG8_BAR; PG8_MMA(1, 1, At, B1); PG8_BAR;
            PG8_LDB(B0, 1, 0); PG8_SCHED; PG8_LDA(At, 1, 0); PG8_STAGE(PG8_SA(0, 1), Abase, a2 + hstepA, voffA);
            PG8_WAIT_L(8); PG8_BAR; PG8_WAIT_L(0); PG8_MMA(0, 0, At, B0); PG8_BAR; PG8_SCHED;
            PG8_LDB(B1, 1, 1); PG8_STAGE(PG8_SB(1, 0), Bbase, b3, voffB);
            PG8_BAR; PG8_WAIT_L(0); PG8_MMA(0, 1, At, B1); PG8_BAR;
            PG8_LDA(At, 1, 1); PG8_STAGE(PG8_SA(1, 0), Abase, a3, voffA);
            PG8_BAR; PG8_WAIT_L(0); PG8_MMA(1, 0, At, B0); PG8_BAR; PG8_SCHED;
            PG8_STAGE(PG8_SB(1, 1), Bbase, b3 + hstepB, voffB);
            PG8_WAIT_V(6); PG8_BAR; PG8_MMA(1, 1, At, B1); PG8_BAR;
        }
        E(acc, cur, wr, wc, fr, fq);
        if (!has_next) break;
#pragma unroll
        for (int a = 0; a < 2; ++a)
#pragma unroll
            for (int b = 0; b < 2; ++b)
#pragma unroll
                for (int m = 0; m < 4; ++m)
#pragma unroll
                    for (int n = 0; n < 2; ++n) acc[a][b][m][n] = (f32x4){0.f, 0.f, 0.f, 0.f};
        cur = nxt; cA = nA; cB = nB; ++ui;
    }
    PG8_WAIT_V(0);
    if (wr == 0) PG8_BAR;
    PG8_BAR;
#undef PG8_SA
#undef PG8_SB
#undef PG8_STAGE
#undef PG8_LDA
#undef PG8_LDB
#undef PG8_MMA
#undef PG8_WAIT_V
#undef PG8_WAIT_L
#undef PG8_BAR
#undef PG8_SCHED
#undef PG8_AOFF
#undef PG8_BOFF
}

template <size_t O0, int LD0, int F0, int PN1 = (1 << 20), size_t O1 = 0, int LD1 = 0, int F1 = 0, int PN2 = (1 << 20), size_t O2 = 0, int LD2 = 0, int F2 = 0, int PN3 = (1 << 20), size_t O3 = 0, int LD3 = 0, int F3 = 0>
struct SegCfg { static constexpr size_t o0 = O0, o1 = O1, o2 = O2, o3 = O3; static constexpr int ld0 = LD0, ld1 = LD1, ld2 = LD2, ld3 = LD3, f0 = F0, f1 = F1, f2 = F2, f3 = F3, pn1 = PN1, pn2 = PN2, pn3 = PN3; };
template <class SG, bool RS, bool NT = false>
struct EpiStore {
    unsigned char* ws; const float* rowscale;
    __device__ __forceinline__ void operator()(const f32x4 (&acc)[2][2][4][2], const Unit& u, int wr, int wc, int fr, int fq) const {
        size_t so; int ldc, pnb; bool isf;
        if (u.pn >= SG::pn3) { so = SG::o3; ldc = SG::ld3; pnb = SG::pn3; isf = SG::f3 != 0; }
        else if (u.pn >= SG::pn2) { so = SG::o2; ldc = SG::ld2; pnb = SG::pn2; isf = SG::f2 != 0; }
        else if (u.pn >= SG::pn1) { so = SG::o1; ldc = SG::ld1; pnb = SG::pn1; isf = SG::f1 != 0; }
        else { so = SG::o0; ldc = SG::ld0; pnb = 0; isf = SG::f0 != 0; }
        unsigned char* base = ws + so;
        const int row0 = u.pm * BM + wr * 64 + fr, col0 = (u.pn - pnb) * BM + wc * 32 + 8 * fq;
#pragma unroll
        for (int ai = 0; ai < 2; ++ai)
#pragma unroll
            for (int m = 0; m < 4; ++m) {
                const int row = row0 + ai * HALF + m * 16;
                const float rs = RS ? rowscale[row] : 1.f;
#pragma unroll
                for (int bj = 0; bj < 2; ++bj) {
                    f32x4 v0 = acc[ai][bj][m][0], v1 = acc[ai][bj][m][1];
                    if (RS) { v0 *= rs; v1 *= rs; }
                    const size_t off = (size_t)row * ldc + col0 + bj * HALF;
                    if (isf) { float* o = (float*)base + off; *(f32x4*)o = v0; *(f32x4*)(o + 4) = v1; }
                    else { u32x4 w; w.x = cvt_pk_bf16(v0[0], v0[1]); w.y = cvt_pk_bf16(v0[2], v0[3]); w.z = cvt_pk_bf16(v1[0], v1[1]); w.w = cvt_pk_bf16(v1[2], v1[3]);
                        if (NT) __builtin_nontemporal_store(w, (u32x4*)((bf16_t*)base + off)); else *(u32x4*)((bf16_t*)base + off) = w; }
                }
                if (RS && (m & 1)) asm volatile("" ::: "memory");
            }
    }
};
template <int SPLIT, int N>
struct EpiPart {
    float* part;
    __device__ __forceinline__ void operator()(const f32x4 (&acc)[2][2][4][2], const Unit& u, int wr, int wc, int fr, int fq) const {
        const int pt = u.pn % SPLIT, ct = u.pn / SPLIT;
        float* base = part + (size_t)pt * 256 * N + ct * BM + wc * 32 + 8 * fq;
#pragma unroll
        for (int ai = 0; ai < 2; ++ai)
#pragma unroll
            for (int m = 0; m < 4; ++m) {
                const int row = wr * 64 + fr + ai * HALF + m * 16;
#pragma unroll
                for (int bj = 0; bj < 2; ++bj) { float* o = base + (size_t)row * N + bj * HALF; *(f32x4*)o = acc[ai][bj][m][0]; *(f32x4*)(o + 4) = acc[ai][bj][m][1]; }
            }
    }
};
struct EpiPool {
    bf16_t* out; const bf16_t* z; const float* scale; int ld;
    __device__ __forceinline__ void operator()(const f32x4 (&acc)[2][2][4][2], const Unit& u, int wr, int wc, int fr, int fq) const {
        const int row0 = u.pm * BM + wr * 64 + fr, col0 = u.pn * BM + wc * 32 + 8 * fq;
        f32x4 sc[2][2];
#pragma unroll
        for (int bj = 0; bj < 2; ++bj) { sc[bj][0] = *(const f32x4*)(scale + col0 + bj * HALF); sc[bj][1] = *(const f32x4*)(scale + col0 + bj * HALF + 4); }
#pragma unroll
        for (int ai = 0; ai < 2; ++ai)
#pragma unroll
            for (int m = 0; m < 4; ++m) {
                const int row = row0 + ai * HALF + m * 16;
#pragma unroll
                for (int bj = 0; bj < 2; ++bj) {
                    const size_t off = (size_t)row * ld + col0 + bj * HALF;
                    const u32x4 zz = *(const u32x4*)(z + off);
                    f32x4 v0 = acc[ai][bj][m][0] * sc[bj][0], v1 = acc[ai][bj][m][1] * sc[bj][1];
                    v0[0] *= silu_f(bf_lo(zz.x)); v0[1] *= silu_f(bf_hi(zz.x)); v0[2] *= silu_f(bf_lo(zz.y)); v0[3] *= silu_f(bf_hi(zz.y));
                    v1[0] *= silu_f(bf_lo(zz.z)); v1[1] *= silu_f(bf_hi(zz.z)); v1[2] *= silu_f(bf_lo(zz.w)); v1[3] *= silu_f(bf_hi(zz.w));
                    u32x4 w; w.x = cvt_pk_bf16(v0[0], v0[1]); w.y = cvt_pk_bf16(v0[2], v0[3]); w.z = cvt_pk_bf16(v1[0], v1[1]); w.w = cvt_pk_bf16(v1[2], v1[3]);
                    *(u32x4*)(out + off) = w;
                }
            }
    }
};
}

namespace att {
constexpr int QBLK = 32, KVBLK = 64;
constexpr float SCALE = 0.07216878364870322f;
constexpr float THR = 8.f;
constexpr int LDQ = 6144, LDKV = 8192, LDR = 64, LDO = 4096;
constexpr int SHM_V = KVBLK * 128 * 2, SHM_K = KVBLK * 400;
#define KSWZ(row, colB) ((row) * 400 + (colB))
#define SBAR() __builtin_amdgcn_sched_barrier(0)
__device__ __forceinline__ int crow(int r, int hi) { return (r & 3) + 8 * (r >> 2) + 4 * hi; }

__device__ __forceinline__ void partialSM(f32x16& p0, f32x16& p1, float& m_reg, float& mn, float& alpha) {
    constexpr float C = SCALE * 1.4426950408889634f;
    float pmax = p0[0];
#pragma unroll
    for (int r = 1; r < 16; ++r) pmax = fmaxf(pmax, p0[r]);
#pragma unroll
    for (int r = 0; r < 16; ++r) pmax = fmaxf(pmax, p1[r]);
    { auto rr = __builtin_amdgcn_permlane32_swap(__float_as_uint(pmax), __float_as_uint(pmax), false, false);
      pmax = fmaxf(__uint_as_float(rr[0]), __uint_as_float(rr[1])); }
    if (__builtin_expect(__all(pmax - m_reg <= THR / SCALE), 1)) { mn = m_reg; alpha = 1.f; }
    else { mn = fmaxf(m_reg, pmax); alpha = __builtin_amdgcn_exp2f((m_reg - mn) * C); m_reg = mn; }
    float mnC = -mn * C;
#pragma unroll
    for (int r = 0; r < 16; ++r) p0[r] = fmaf(p0[r], C, mnC);
#pragma unroll
    for (int r = 0; r < 16; ++r) p1[r] = fmaf(p1[r], C, mnC);
#pragma unroll
    for (int r = 0; r < 16; ++r) p0[r] = __builtin_amdgcn_exp2f(p0[r]);
}
__device__ __forceinline__ void finishSM(f32x16& p0, f32x16& p1, float alpha, float& l_reg, bf16x8& pa0, bf16x8& pa1, bf16x8& pa2, bf16x8& pa3) {
#pragma unroll
    for (int r = 0; r < 16; ++r) p1[r] = __builtin_amdgcn_exp2f(p1[r]);
    float ps = 0;
#pragma unroll
    for (int r = 0; r < 16; ++r) ps += p0[r];
#pragma unroll
    for (int r = 0; r < 16; ++r) ps += p1[r];
    { auto rr = __builtin_amdgcn_permlane32_swap(__float_as_uint(ps), __float_as_uint(ps), false, false);
      ps = __uint_as_float(rr[0]) + __uint_as_float(rr[1]); }
    l_reg = l_reg * alpha + ps;
#define PK4(P, BASE, OUT) do { unsigned a0 = cvt_pk_bf16(P[BASE + 0], P[BASE + 1]), a1 = cvt_pk_bf16(P[BASE + 2], P[BASE + 3]);   \
    unsigned b0 = cvt_pk_bf16(P[BASE + 4], P[BASE + 5]), b1 = cvt_pk_bf16(P[BASE + 6], P[BASE + 7]);                              \
    auto r0 = __builtin_amdgcn_permlane32_swap(a0, b0, false, false); auto r1 = __builtin_amdgcn_permlane32_swap(a1, b1, false, false); \
    u32x4 w = {r0[0], r1[0], r0[1], r1[1]}; OUT = *reinterpret_cast<bf16x8*>(&w); } while (0)
    PK4(p0, 0, pa0); PK4(p0, 8, pa1); PK4(p1, 0, pa2); PK4(p1, 8, pa3);
#undef PK4
}
__device__ __forceinline__ void qkt(f32x16& p0, f32x16& p1, const char* Ks, const bf16x8* qr, int r32, int hi) {
    p0 = f32x16{}; p1 = f32x16{};
#pragma unroll
    for (int d0 = 0; d0 < 12; ++d0) { int cb = (d0 * 16 + hi * 8) * 2;
        bf16x8 b0 = *reinterpret_cast<const bf16x8*>(Ks + KSWZ(r32, cb));
        bf16x8 b1 = *reinterpret_cast<const bf16x8*>(Ks + KSWZ(32 + r32, cb));
        p0 = __builtin_amdgcn_mfma_f32_32x32x16_bf16(b0, qr[d0], p0, 0, 0, 0);
        p1 = __builtin_amdgcn_mfma_f32_32x32x16_bf16(b1, qr[d0], p1, 0, 0, 0); }
}
__device__ __forceinline__ int v_st(int k, int c) { const int kk = (k & ~0xC) | ((k & 4) << 1) | ((k & 8) >> 1); return ((kk >> 3) * 4 + (c >> 5)) * 512 + ((kk & 7) * 32 + (c & 31)) * 2; }
__device__ __forceinline__ int v_rd_base(int lane) { return ((lane & 3) << 3) | (((lane >> 2) & 3) << 6) | (((lane >> 4) & 1) << 5) | (((lane >> 5) & 1) << 8); }
constexpr int v_rd_off(int d0, int ks, int half) { return d0 * 512 + ks * 4096 + half * 2048; }
template <int OFF> __device__ __forceinline__ s16x4 tr_read(int vb) {
    s16x4 r; asm volatile("ds_read_b64_tr_b16 %0, %1 offset:%2" : "=&v"(r) : "v"(vb), "i"(OFF) : "memory"); return r;
}
template <int D0> __device__ __forceinline__ void pv_one(f32x16& od, int vb, bf16x8 pa0, bf16x8 pa1, bf16x8 pa2, bf16x8 pa3) {
    const s16x4 l0 = tr_read<v_rd_off(D0, 0, 0)>(vb), h0 = tr_read<v_rd_off(D0, 0, 1)>(vb), l1 = tr_read<v_rd_off(D0, 1, 0)>(vb), h1 = tr_read<v_rd_off(D0, 1, 1)>(vb);
    const s16x4 l2 = tr_read<v_rd_off(D0, 2, 0)>(vb), h2 = tr_read<v_rd_off(D0, 2, 1)>(vb), l3 = tr_read<v_rd_off(D0, 3, 0)>(vb), h3 = tr_read<v_rd_off(D0, 3, 1)>(vb);
    asm volatile("s_waitcnt lgkmcnt(0)" ::: "memory"); SBAR();
#define PK(L, H) (bf16x8){L[0], L[1], L[2], L[3], H[0], H[1], H[2], H[3]}
    od = __builtin_amdgcn_mfma_f32_32x32x16_bf16(pa0, PK(l0, h0), od, 0, 0, 0);
    od = __builtin_amdgcn_mfma_f32_32x32x16_bf16(pa1, PK(l1, h1), od, 0, 0, 0);
    od = __builtin_amdgcn_mfma_f32_32x32x16_bf16(pa2, PK(l2, h2), od, 0, 0, 0);
    od = __builtin_amdgcn_mfma_f32_32x32x16_bf16(pa3, PK(l3, h3), od, 0, 0, 0);
#undef PK
}
__device__ __forceinline__ void pv_d0(f32x16* o, int vb, bf16x8 pa0, bf16x8 pa1, bf16x8 pa2, bf16x8 pa3) {
    pv_one<0>(o[0], vb, pa0, pa1, pa2, pa3); pv_one<1>(o[1], vb, pa0, pa1, pa2, pa3); pv_one<2>(o[2], vb, pa0, pa1, pa2, pa3); pv_one<3>(o[3], vb, pa0, pa1, pa2, pa3);
}
__device__ __forceinline__ void pv_psm(f32x16* o, int vb, bf16x8 pa0, bf16x8 pa1, bf16x8 pa2, bf16x8 pa3, f32x16& p0, f32x16& p1, float& m_reg, float& mn, float& alpha) {
    constexpr float C = SCALE * 1.4426950408889634f;
    pv_one<0>(o[0], vb, pa0, pa1, pa2, pa3);
    float pmax = p0[0];
#pragma unroll
    for (int r = 1; r < 16; ++r) pmax = fmaxf(pmax, p0[r]);
    pv_one<1>(o[1], vb, pa0, pa1, pa2, pa3);
#pragma unroll
    for (int r = 0; r < 16; ++r) pmax = fmaxf(pmax, p1[r]);
    { auto rr = __builtin_amdgcn_permlane32_swap(__float_as_uint(pmax), __float_as_uint(pmax), false, false);
      pmax = fmaxf(__uint_as_float(rr[0]), __uint_as_float(rr[1])); }
    if (__builtin_expect(__all(pmax - m_reg <= THR / SCALE), 1)) { mn = m_reg; alpha = 1.f; }
    else { mn = fmaxf(m_reg, pmax); alpha = __builtin_amdgcn_exp2f((m_reg - mn) * C); m_reg = mn; }
    const float mnC = -mn * C;
    pv_one<2>(o[2], vb, pa0, pa1, pa2, pa3);
#pragma unroll
    for (int r = 0; r < 16; ++r) p0[r] = fmaf(p0[r], C, mnC);
#pragma unroll
    for (int r = 0; r < 16; ++r) p0[r] = __builtin_amdgcn_exp2f(p0[r]);
    pv_one<3>(o[3], vb, pa0, pa1, pa2, pa3);
#pragma unroll
    for (int r = 0; r < 16; ++r) p1[r] = fmaf(p1[r], C, mnC);
}

__device__ __forceinline__ void attn_body(const bf16_t* __restrict__ Qb, const bf16_t* __restrict__ Kn, const bf16_t* __restrict__ Kr, const bf16_t* __restrict__ Vh,
                                          const bf16_t* __restrict__ Zb, bf16_t* __restrict__ Ob, int seq, char* lds, int wave, const float* __restrict__ rope  ) {
    const int tid = tid_opaque(wave), wid = wave, lane = tid & 63, r32 = lane & 31, hi = lane >> 5;
    char* V_lds = lds; char* K_lds = lds + 2 * SHM_V;
    float* ws = (float*)(lds + 2 * SHM_V + 2 * SHM_K) + wid * 64; float* li_l = ws; float* al_l = ws + 32;
    float m_reg = -1e30f, l_reg = 0; f32x16 o[4] = {}; bf16x8 qr[12];
    const bf16_t* Qw = Qb + (long)(wid * QBLK + r32) * LDQ + hi * 8;
#pragma unroll
    for (int d0 = 0; d0 < 12; ++d0) qr[d0] = *reinterpret_cast<const bf16x8*>(Qw + d0 * 16);
    if (rope) {
        const float* tp = rope + (size_t)(wid * QBLK + r32) * 64 + hi * 8;
#pragma unroll
        for (int h = 0; h < 2; ++h) {
            const f32x4 c0 = *(const f32x4*)(tp + 16 * h), c1 = *(const f32x4*)(tp + 16 * h + 4), s0 = *(const f32x4*)(tp + 32 + 16 * h), s1 = *(const f32x4*)(tp + 32 + 16 * h + 4);
            const u32x4 a = *reinterpret_cast<const u32x4*>(&qr[8 + h]), b = *reinterpret_cast<const u32x4*>(&qr[10 + h]);
            u32x4 oa, ob;
#define ROT(W, CA, CB, SA, SB) do { const float x1l = bf_lo(a.W), x1h = bf_hi(a.W), x2l = bf_lo(b.W), x2h = bf_hi(b.W); \
            oa.W = cvt_pk_bf16(x1l * (CA) - x2l * (SA), x1h * (CB) - x2h * (SB)); ob.W = cvt_pk_bf16(x1l * (SA) + x2l * (CA), x1h * (SB) + x2h * (CB)); } while (0)
            ROT(x, c0[0], c0[1], s0[0], s0[1]); ROT(y, c0[2], c0[3], s0[2], s0[3]); ROT(z, c1[0], c1[1], s1[0], s1[1]); ROT(w, c1[2], c1[3], s1[2], s1[3]);
#undef ROT
            qr[8 + h] = *reinterpret_cast<const bf16x8*>(&oa); qr[10 + h] = *reinterpret_cast<const bf16x8*>(&ob);
        }
    }
    const int sr = tid >> 4, sc = (tid & 15) * 8, vst0 = v_st(sr, sc), vst1 = v_st(32 + sr, sc);
    const int rr_ = tid >> 3, rc_ = (tid & 7) * 8;
    const int vb0 = (int)(uintptr_t)V_lds + v_rd_base(lane);
    bf16x8 vs0, vs1, ks0, ks1, kr0;
    const unsigned oV0 = (unsigned)(sr * LDKV + sc), oV1 = (unsigned)((32 + sr) * LDKV + sc), oR = (unsigned)(rr_ * LDR + rc_);
#define SLOAD(k0) do { const bf16_t* vt_ = Vh + (size_t)(k0) * LDKV; const bf16_t* kt_ = Kn + (size_t)(k0) * LDKV; const bf16_t* rt_ = Kr + (size_t)(k0) * LDR; \
    vs0 = *reinterpret_cast<const bf16x8*>(vt_ + oV0); vs1 = *reinterpret_cast<const bf16x8*>(vt_ + oV1); \
    ks0 = *reinterpret_cast<const bf16x8*>(kt_ + oV0); ks1 = *reinterpret_cast<const bf16x8*>(kt_ + oV1); \
    kr0 = *reinterpret_cast<const bf16x8*>(rt_ + oR); } while (0)
#define SWRITE(b) do { *(bf16x8*)(V_lds + (b) * SHM_V + vst0) = vs0; *(bf16x8*)(V_lds + (b) * SHM_V + vst1) = vs1; int kc = sc * 2;  \
    *(bf16x8*)(K_lds + (b) * SHM_K + KSWZ(sr, kc)) = ks0; *(bf16x8*)(K_lds + (b) * SHM_K + KSWZ(32 + sr, kc)) = ks1;                      \
    *(bf16x8*)(K_lds + (b) * SHM_K + KSWZ(rr_, 256 + rc_ * 2)) = kr0; } while (0)
#define SWAIT() asm volatile("s_waitcnt vmcnt(0)" ::: "memory")
#define RESC(a) do { if (__any((a) < 1.f)) { if (hi == 0) al_l[r32] = (a); asm volatile("s_waitcnt lgkmcnt(0)" ::: "memory"); \
    _Pragma("unroll") for (int d = 0; d < 4; ++d) _Pragma("unroll") for (int r = 0; r < 16; ++r) o[d][r] *= al_l[crow(r, hi)]; } } while (0)
    f32x16 pA0, pA1, pB0, pB1; float mnA, mnB, alA, alB; bf16x8 pa0, pa1, pa2, pa3; const int NT = seq / KVBLK;
    SLOAD(0); SWAIT(); SWRITE(0); __syncthreads();
    qkt(pA0, pA1, K_lds, qr, r32, hi); partialSM(pA0, pA1, m_reg, mnA, alA);
    SLOAD(KVBLK);
    SWAIT(); SWRITE(1); __syncthreads();
    for (int j = 1; j + 1 < NT; j += 2) {
        SBAR(); qkt(pB0, pB1, K_lds + SHM_K, qr, r32, hi);
        finishSM(pA0, pA1, alA, l_reg, pa0, pa1, pa2, pa3); SBAR();
        SLOAD((j + 1) * KVBLK); SBAR();
        pv_psm(o, vb0, pa0, pa1, pa2, pa3, pB0, pB1, m_reg, mnB, alB);
        __syncthreads(); SWAIT(); SWRITE(0);
        RESC(alB); __syncthreads();
        SBAR(); qkt(pA0, pA1, K_lds, qr, r32, hi);
        finishSM(pB0, pB1, alB, l_reg, pa0, pa1, pa2, pa3); SBAR();
        SLOAD((j + 2) * KVBLK); SBAR();
        pv_psm(o, vb0 + SHM_V, pa0, pa1, pa2, pa3, pA0, pA1, m_reg, mnA, alA);
        __syncthreads(); SWAIT(); SWRITE(1);
        RESC(alA); __syncthreads();
    }
    SBAR(); qkt(pB0, pB1, K_lds + SHM_K, qr, r32, hi);
    finishSM(pA0, pA1, alA, l_reg, pa0, pa1, pa2, pa3); SBAR();
    pv_psm(o, vb0, pa0, pa1, pa2, pa3, pB0, pB1, m_reg, mnB, alB);
    __syncthreads(); RESC(alB);
    finishSM(pB0, pB1, alB, l_reg, pa0, pa1, pa2, pa3); SBAR();
    pv_d0(o, vb0 + SHM_V, pa0, pa1, pa2, pa3);
    if (hi == 0) li_l[r32] = l_reg; asm volatile("s_waitcnt lgkmcnt(0)" ::: "memory");
    float rli[16];
#pragma unroll
    for (int r = 0; r < 16; ++r) rli[r] = __builtin_amdgcn_rcpf(li_l[crow(r, hi)]);
    unsigned wrow = (unsigned)((wid * QBLK + 4 * hi) * LDO + r32);
    asm volatile("" : "+v"(wrow));
#pragma unroll
    for (int r = 0; r < 16; ++r) { const unsigned off = wrow + (unsigned)(((r & 3) + 8 * (r >> 2)) * LDO);
#pragma unroll
        for (int d0 = 0; d0 < 4; ++d0) { const float z = bf2f(Zb[off + d0 * 32]); Ob[off + d0 * 32] = f2bf(o[d0][r] * rli[r] * silu_f(z)); }
        if (r & 1) asm volatile("" ::: "memory"); }
#undef SLOAD
#undef SWRITE
#undef SWAIT
#undef RESC
}
}

struct TJob { const float* src; const float* scale; bf16_t* dst; int ld_src; int K; int ncols; int tile0; };
struct Params {
    const float* in[24]; float* out; unsigned char* ws;
    int ph_lo, ph_hi, njobs, ntiles, ntiles_early, pad_, ntiles_l3, pad2_;
    TJob jobs[24];
};
struct Ctx { int tid, lane, wave, bid, G; unsigned char* ws; LAS unsigned char* lds; };

__device__ __forceinline__ void ph_adaln(const Ctx& C, const Params& p, const int u0, const int u1, const int b0) {
    LAS float* sl = (LAS float*)C.lds;
    LAS float* red = (LAS float*)(C.lds + 32768);
    if (C.bid >= b0 && u0 + (C.bid - b0) < u1) {
        for (int k = C.tid; k < 4096; k += 512) { sl[k] = silu_f(p.in[1][k]); sl[4096 + k] = silu_f(p.in[3][k]); }
        __syncthreads();
    }
    if (C.bid >= b0)
    for (int u = u0 + (C.bid - b0); u < u1; u += C.G) {
        const int layer = u / 48, col0 = (u % 48) * 256;
        const float* w = p.in[4] + (size_t)layer * 4096 * 12288 + col0 + 4 * C.lane;
        f32x4 al = {0.f, 0.f, 0.f, 0.f}, ac = {0.f, 0.f, 0.f, 0.f};
        for (int k0 = C.wave; k0 < 4096; k0 += 128) {
            f32x4 wv[16];
#pragma unroll
            for (int i = 0; i < 16; ++i) wv[i] = *(const f32x4*)(w + (size_t)(k0 + 8 * i) * 12288);
#pragma unroll
            for (int i = 0; i < 16; ++i) { const float a = sl[k0 + 8 * i], b = sl[4096 + k0 + 8 * i]; al += wv[i] * a; ac += wv[i] * b; }
        }
#pragma unroll
        for (int j = 0; j < 4; ++j) { red[(C.wave * 256 + 4 * C.lane + j) * 2 + 0] = al[j]; red[(C.wave * 256 + 4 * C.lane + j) * 2 + 1] = ac[j]; }
        __syncthreads();
        { const int cond = C.tid >> 8, col = C.tid & 255; float s = 0.f;
#pragma unroll
          for (int wv = 0; wv < 8; ++wv) s += red[(wv * 256 + col) * 2 + cond];
          float* mod = (float*)(C.ws + WS_MOD);
          mod[((size_t)layer * 2 + cond) * 12288 + col0 + col] = s + p.in[5][(size_t)layer * 12288 + col0 + col]; }
        __syncthreads();
    }
}
struct WTile { f32x4 a0, a1, b0, b1; bf16_t* dst; int K, n0, k0; };
__device__ __forceinline__ void wconv_load(const Params& p, int tix, int tid, WTile& t) {
    int j = 0;
    while (j + 1 < p.njobs && tix >= p.jobs[j + 1].tile0) ++j;
    const TJob jb = p.jobs[j];
    const int local = tix - jb.tile0, nkt = jb.K / 128, nb = local / nkt, kb = local - nb * nkt;
    t.dst = jb.dst; t.K = jb.K; t.n0 = nb * 64; t.k0 = kb * 128;
    const int kp = (tid >> 3) * 2, nq = (tid & 7) * 8;
    t.a0 = (f32x4){0.f, 0.f, 0.f, 0.f}; t.a1 = t.a0; t.b0 = t.a0; t.b1 = t.a0;
    if (jb.src) {
        const float* s0 = jb.src + (size_t)(t.k0 + kp) * jb.ld_src + t.n0 + nq;
        t.a0 = *(const f32x4*)s0; t.a1 = *(const f32x4*)(s0 + 4); t.b0 = *(const f32x4*)(s0 + jb.ld_src); t.b1 = *(const f32x4*)(s0 + jb.ld_src + 4);
        if (jb.scale) { const float sa = jb.scale[t.k0 + kp], sb = jb.scale[t.k0 + kp + 1]; t.a0 *= sa; t.a1 *= sa; t.b0 *= sb; t.b1 *= sb; }
    }
}
constexpr int ADA_W = 64;
template <int MODE>
__device__ __forceinline__ void ph_wconv(const Ctx& C, const Params& p, const int t0, const int t1) {
    LAS unsigned* T = (LAS unsigned*)C.lds;
    const int nt_ = t1 - t0;
    int n1, n2, nb, b;
    int na = 0;
    if (MODE == 2) { if (C.bid < 129) return; nb = C.G - 129; b = C.bid - 129; n1 = (nt_ + nb - 1) / nb; n2 = 0; }
    else if (MODE == 3) { if (C.bid < 32) return; nb = C.G - 32; b = C.bid - 32; n1 = (nt_ + nb - 1) / nb; n2 = 0; }
    else if (MODE == 1) { if (C.G == 256) { if (C.bid < 128) return; nb = 128; b = C.bid - 128; na = 48; n1 = nt_ > 80 * ADA_W ? (nt_ - 80 * ADA_W) / 128 : 0; n2 = b >= 48 ? (nt_ - n1 * 128 + 79) / 80 : 0; }
        else { if (C.G > 128) { if (C.bid < 128) return; nb = C.G - 128; b = C.bid - 128; } else { nb = C.G; b = C.bid; }
            n1 = (nt_ + nb - 1) / nb; n2 = 0; } }
    else if (C.G == 256 && nt_ > 256 * 32) { nb = 256; b = C.bid; na = 144; n1 = (nt_ - 112 * ADA_W) / 256; n2 = C.bid >= 144 ? (nt_ - n1 * 256 + 111) / 112 : 0; }
    else { nb = C.G; b = C.bid; n1 = (nt_ + C.G - 1) / C.G; n2 = 0; }
#define WC_TIX(i) (t0 + ((i) < n1 ? (i) * nb + b : n1 * nb + ((i) - n1) * (nb - na) + (b - na)))
    WTile cur, nxt, nx2;
    if (n1 + n2 > 0 && WC_TIX(0) < t1) wconv_load(p, WC_TIX(0), C.tid, cur);
    if (n1 + n2 > 1 && WC_TIX(1) < t1) wconv_load(p, WC_TIX(1), C.tid, nxt);
    for (int i = 0; i < n1 + n2; ++i) {
        const int tix = WC_TIX(i);
        if (tix >= t1) break;
        if (i + 2 < n1 + n2 && WC_TIX(i + 2) < t1) wconv_load(p, WC_TIX(i + 2), C.tid, nx2);
        { const int kp = (C.tid >> 3) * 2, nq = (C.tid & 7) * 8;
#pragma unroll
          for (int q = 0; q < 4; ++q) { T[(nq + q) * 65 + (kp >> 1)] = cvt_pk_bf16(cur.a0[q], cur.b0[q]); T[(nq + 4 + q) * 65 + (kp >> 1)] = cvt_pk_bf16(cur.a1[q], cur.b1[q]); } }
        __syncthreads();
#pragma unroll
        for (int r_ = 0; r_ < 2; ++r_) { const int c = C.tid & 15, n = (C.tid >> 4) + 32 * r_;
            u32x4 v; v.x = T[n * 65 + c * 4]; v.y = T[n * 65 + c * 4 + 1]; v.z = T[n * 65 + c * 4 + 2]; v.w = T[n * 65 + c * 4 + 3];
            *(u32x4*)(cur.dst + (size_t)(cur.n0 + n) * cur.K + cur.k0 + c * 8) = v; }
        __syncthreads();
        cur = nxt; nxt = nx2;
    }
#undef WC_TIX
}
__device__ __forceinline__ void ph_rope_table(const Ctx& C) {
    float* tab = (float*)(C.ws + WS_ROPE);
    for (int idx = C.bid * 512 + C.tid; idx < 8192 * 32; idx += C.G * 512) {
        const int pos = idx >> 5, f = idx & 31, i = f & 15;
        const float inv = powf(10000.0f, -(float)i / 16.0f);
        const float ang = (float)((f < 16) ? (pos >> 6) : (pos & 63)) * inv;
        tab[pos * 64 + f] = cosf(ang); tab[pos * 64 + 32 + f] = sinf(ang);
    }
}

template <int MODE>
__device__ __forceinline__ void rows_ctx(const Ctx& C, const Params& p, int layer, int nlayer) {
    const float* mod = (const float*)(C.ws + WS_MOD);
    bf16_t* h = (bf16_t*)(C.ws + WS_H);
    float* xc = (float*)(C.ws + WS_XC);
    const float* ypart = (const float*)(C.ws + WS_YPART);
    LAS float* red = (LAS float*)C.lds;
    for (int row = C.bid; row < NCTX; row += C.G) {
        const int c = 8 * C.tid;
        const float* xsrc = (MODE == 0 || layer == 0) ? p.in[2] + (size_t)row * DM : xc + (size_t)row * DM;
        f32x4 x0 = *(const f32x4*)(xsrc + c), x1 = *(const f32x4*)(xsrc + c + 4);
        if (MODE >= 1) {
            const unsigned voff = (unsigned)c * 4u;
            f32x4 y0 = {0.f, 0.f, 0.f, 0.f}, y1 = y0;
#pragma unroll
            for (int hb = 0; hb < YPARTS; hb += 8) {
                f32x4 pa[8], pb[8];
#pragma unroll
                for (int pt = 0; pt < 8; ++pt) { const char* pp = (const char*)(ypart + ((size_t)(hb + pt) * 256 + row) * DM); pa[pt] = *(const f32x4*)(pp + voff); pb[pt] = *(const f32x4*)(pp + voff + 16); }
#pragma unroll
                for (int pt = 0; pt < 8; ++pt) { y0 += pa[pt]; y1 += pb[pt]; }
            }
            float ss = y0[0] * y0[0] + y0[1] * y0[1] + y0[2] * y0[2] + y0[3] * y0[3] + y1[0] * y1[0] + y1[1] * y1[1] + y1[2] * y1[2] + y1[3] * y1[3];
            ss = wave_sum(ss);
            if (C.lane == 0) red[C.wave] = ss;
            __syncthreads();
            float tot = 0.f;
#pragma unroll
            for (int w = 0; w < 8; ++w) tot += red[w];
            const float rs = rsqrtf(tot * (1.f / DM) + EPS);
            const float* gt = mod + ((size_t)layer * 2 + 1) * 12288 + 8192 + c;
            const float* np = p.in[7] + (size_t)layer * DM + c;
            x0 += *(const f32x4*)gt * (y0 * rs * *(const f32x4*)np); x1 += *(const f32x4*)(gt + 4) * (y1 * rs * *(const f32x4*)(np + 4));
            *(f32x4*)(xc + (size_t)row * DM + c) = x0; *(f32x4*)(xc + (size_t)row * DM + c + 4) = x1;
        }
        {
            float ss = x0[0] * x0[0] + x0[1] * x0[1] + x0[2] * x0[2] + x0[3] * x0[3] + x1[0] * x1[0] + x1[1] * x1[1] + x1[2] * x1[2] + x1[3] * x1[3];
            ss = wave_sum(ss);
            if (C.lane == 0) red[8 + C.wave] = ss;
            __syncthreads();
            float tot = 0.f;
#pragma unroll
            for (int w = 0; w < 8; ++w) tot += red[8 + w];
            const float rs = rsqrtf(tot * (1.f / DM) + EPS);
            const float* sh = mod + ((size_t)nlayer * 2 + 1) * 12288 + c; const float* sc = sh + 4096;
            const float* np = p.in[6] + (size_t)nlayer * DM + c;
            const f32x4 v0 = (x0 * rs * *(const f32x4*)np) * (*(const f32x4*)sc + 1.f) + *(const f32x4*)sh;
            const f32x4 v1 = (x1 * rs * *(const f32x4*)(np + 4)) * (*(const f32x4*)(sc + 4) + 1.f) + *(const f32x4*)(sh + 4);
            u32x4 w; w.x = cvt_pk_bf16(v0[0], v0[1]); w.y = cvt_pk_bf16(v0[2], v0[3]); w.z = cvt_pk_bf16(v1[0], v1[1]); w.w = cvt_pk_bf16(v1[2], v1[3]);
            *(u32x4*)(h + (size_t)row * DM + c) = w;
        }
        __syncthreads();
    }
}
template <int MODE, bool XF32>
__device__ __forceinline__ void rows_lat_one(const Ctx& C, const Params& p, const int layer, const int nlayer, const int row, f32x4 (&xv)[16], const u32x2 (&xw)[16], const u32x2 (&yw)[16]) {
    int ln = C.lane; asm volatile("" : "+v"(ln));
    const float* mod = (const float*)(C.ws + WS_MOD);
    if (!XF32) {
#pragma unroll
        for (int q = 0; q < 16; ++q) xv[q] = (f32x4){bf_lo(xw[q].x), bf_hi(xw[q].x), bf_lo(xw[q].y), bf_hi(xw[q].y)};
    }
    if (MODE >= 1) {
        float ss = 0.f;
#pragma unroll
        for (int q = 0; q < 16; ++q) { const float a = bf_lo(yw[q].x), b = bf_hi(yw[q].x), c_ = bf_lo(yw[q].y), d = bf_hi(yw[q].y); ss += a * a + b * b + c_ * c_ + d * d; }
        ss = wave_sum(ss);
        __builtin_amdgcn_sched_barrier(0);
        const float rs = rsqrtf(ss * (1.f / DM) + EPS);
        const LAS f32x4* gnl = (const LAS f32x4*)(C.lds + ROWS_PRM) + ln;
        float* xo = p.out + (size_t)(row - NCTX) * DM + 4 * ln; bf16_t* xb = (bf16_t*)(C.ws + WS_XB) + (size_t)(row - NCTX) * DM + 4 * ln;
#pragma unroll
        for (int q = 0; q < 16; ++q) { const f32x4 gn = gnl[64 * q];
            const f32x4 yv = {bf_lo(yw[q].x), bf_hi(yw[q].x), bf_lo(yw[q].y), bf_hi(yw[q].y)};
            xv[q] += gn * (yv * rs);
            if (MODE == 2) __builtin_nontemporal_store(xv[q], (f32x4*)(xo + 256 * q));
            else { u32x2 w; w.x = cvt_pk_bf16(xv[q][0], xv[q][1]); w.y = cvt_pk_bf16(xv[q][2], xv[q][3]); *(u32x2*)(xb + 256 * q) = w; }
            if ((q & 1) == 1) asm volatile("" ::: "memory"); }
    }
    __builtin_amdgcn_sched_barrier(0);
    if (MODE != 2) {
        float ss = 0.f;
#pragma unroll
        for (int q = 0; q < 16; ++q) ss += xv[q][0] * xv[q][0] + xv[q][1] * xv[q][1] + xv[q][2] * xv[q][2] + xv[q][3] * xv[q][3];
        ss = wave_sum(ss);
        __builtin_amdgcn_sched_barrier(0);
        const float rs = rsqrtf(ss * (1.f / DM) + EPS);
        const LAS f32x4* al = (const LAS f32x4*)(C.lds + ROWS_PRM + 16384) + ln;
        bf16_t* ho = (bf16_t*)(C.ws + WS_H) + (size_t)row * DM + 4 * ln;
#pragma unroll
        for (int q = 0; q < 16; ++q) { const f32x4 a = al[64 * q], b = al[1024 + 64 * q];
            const f32x4 v = (xv[q] * rs) * a + b;
            u32x2 w; w.x = cvt_pk_bf16(v[0], v[1]); w.y = cvt_pk_bf16(v[2], v[3]);
            *(u32x2*)(ho + 256 * q) = w; if ((q & 1) == 1) asm volatile("" ::: "memory"); }
    }
    __builtin_amdgcn_sched_barrier(0);
}
template <int MODE, bool XF32, int NR>
__device__ __forceinline__ void rows_lat(const Ctx& C, const Params& p, const int layer, const int nlayer, const int row0, const int stride) {
    const bf16_t* y = (const bf16_t*)(C.ws + WS_Y);
    f32x4 xv[NR][16]; u32x2 xw[NR][16], yw[NR][16];
#pragma unroll
    for (int i = 0; i < NR; ++i) {
        int ln = C.lane; asm volatile("" : "+v"(ln));
        const int row = row0 + i * stride;
        if (XF32) { const float* xsrc = p.in[0] + (size_t)(row - NCTX) * DM + 4 * ln;
#pragma unroll
            for (int q = 0; q < 16; ++q) xv[i][q] = *(const f32x4*)(xsrc + 256 * q);
        } else { const bf16_t* xbr = (const bf16_t*)(C.ws + WS_XB) + (size_t)(row - NCTX) * DM + 4 * ln;
#pragma unroll
            for (int q = 0; q < 16; ++q) xw[i][q] = *(const u32x2*)(xbr + 256 * q);
        }
        if (MODE >= 1) { const bf16_t* yr = y + (size_t)row * DM + 4 * ln;
#pragma unroll
            for (int q = 0; q < 16; ++q) yw[i][q] = *(const u32x2*)(yr + 256 * q);
        }
    }
    __builtin_amdgcn_sched_barrier(0);
#pragma unroll
    for (int i = 0; i < NR; ++i) rows_lat_one<MODE, XF32>(C, p, layer, nlayer, row0 + i * stride, xv[i], xw[i], yw[i]);
}
template <int MODE>
__device__ __forceinline__ void ph_rows(const Ctx& C, const Params& p, int layer  , int nlayer  ) {
    {
        const float* mod = (const float*)(C.ws + WS_MOD);
        LAS f32x4* prm = (LAS f32x4*)(C.lds + ROWS_PRM);
        for (int i = C.tid; i < 1024; i += 512) {
            if (MODE >= 1) prm[i] = *(const f32x4*)(mod + ((size_t)layer * 2) * 12288 + 8192 + 4 * i) * *(const f32x4*)(p.in[7] + (size_t)layer * DM + 4 * i);
            if (MODE != 2) { const float* sh = mod + ((size_t)nlayer * 2) * 12288 + 4 * i;
                prm[1024 + i] = *(const f32x4*)(p.in[6] + (size_t)nlayer * DM + 4 * i) * (*(const f32x4*)(sh + 4096) + 1.f); prm[2048 + i] = *(const f32x4*)sh; }
        }
        __syncthreads();
    }
    if (MODE != 2) rows_ctx<MODE>(C, p, layer, nlayer);
    const int stride = C.G * 8;
    int row = NCTX + C.bid * 8 + C.wave;
    if (MODE == 0) {
        for (; row + stride < TR; row += 2 * stride) rows_lat<MODE, true, 2>(C, p, layer, nlayer, row, stride);
        if (row < TR) rows_lat<MODE, true, 1>(C, p, layer, nlayer, row, stride);
    } else if (layer == 0) {
        for (; row + stride < TR; row += 2 * stride) rows_lat<MODE, true, 2>(C, p, layer, nlayer, row, stride);
        if (row < TR) rows_lat<MODE, true, 1>(C, p, layer, nlayer, row, stride);
    } else {
        for (; row + stride < TR; row += 2 * stride) rows_lat<MODE, false, 2>(C, p, layer, nlayer, row, stride);
        if (row < TR) rows_lat<MODE, false, 1>(C, p, layer, nlayer, row, stride);
    }
}

template <int NR>
__device__ __forceinline__ void mla_stats_rows(const Ctx& C, const int row0, const int stride) {
    const bf16_t* cq = (const bf16_t*)(C.ws + A_CQ); const bf16_t* ckv = (const bf16_t*)(C.ws + A_CKV);
    const float* krraw = (const float*)(C.ws + A_KRRAW); bf16_t* kr = (bf16_t*)(C.ws + A_KR);
    float* rsq = (float*)(C.ws + A_RSQ); float* rskv = (float*)(C.ws + A_RSKV);
    const float* tab = (const float*)(C.ws + WS_ROPE);
    u32x4 va[NR], vb[NR], vk[NR]; float x1[NR], x2[NR], cs[NR], sn[NR];
#pragma unroll
    for (int i = 0; i < NR; ++i) { const int row = row0 + i * stride;
        va[i] = *(const u32x4*)(cq + (size_t)row * 1024 + 8 * C.lane); vb[i] = *(const u32x4*)(cq + (size_t)row * 1024 + 8 * (C.lane + 64));
        vk[i] = *(const u32x4*)(ckv + (size_t)row * 512 + 8 * C.lane);
        x1[i] = 0.f; x2[i] = 0.f; cs[i] = 1.f; sn[i] = 0.f;
        if (C.lane < 32) { x1[i] = krraw[(size_t)row * 256 + C.lane]; x2[i] = krraw[(size_t)row * 256 + 32 + C.lane];
            if (row >= NCTX) { cs[i] = tab[(size_t)(row - NCTX) * 64 + C.lane]; sn[i] = tab[(size_t)(row - NCTX) * 64 + 32 + C.lane]; } } }
#pragma unroll
    for (int i = 0; i < NR; ++i) { const int row = row0 + i * stride;
        float s1 = 0.f, s2 = 0.f;
        { const u32x4 v = va[i]; s1 += bf_lo(v.x) * bf_lo(v.x) + bf_hi(v.x) * bf_hi(v.x) + bf_lo(v.y) * bf_lo(v.y) + bf_hi(v.y) * bf_hi(v.y) + bf_lo(v.z) * bf_lo(v.z) + bf_hi(v.z) * bf_hi(v.z) + bf_lo(v.w) * bf_lo(v.w) + bf_hi(v.w) * bf_hi(v.w); }
        { const u32x4 v = vb[i]; s1 += bf_lo(v.x) * bf_lo(v.x) + bf_hi(v.x) * bf_hi(v.x) + bf_lo(v.y) * bf_lo(v.y) + bf_hi(v.y) * bf_hi(v.y) + bf_lo(v.z) * bf_lo(v.z) + bf_hi(v.z) * bf_hi(v.z) + bf_lo(v.w) * bf_lo(v.w) + bf_hi(v.w) * bf_hi(v.w); }
        { const u32x4 v = vk[i]; s2 += bf_lo(v.x) * bf_lo(v.x) + bf_hi(v.x) * bf_hi(v.x) + bf_lo(v.y) * bf_lo(v.y) + bf_hi(v.y) * bf_hi(v.y) + bf_lo(v.z) * bf_lo(v.z) + bf_hi(v.z) * bf_hi(v.z) + bf_lo(v.w) * bf_lo(v.w) + bf_hi(v.w) * bf_hi(v.w); }
        s1 = wave_sum(s1); s2 = wave_sum(s2);
        if (C.lane == 0) { rsq[row] = rsqrtf(s1 * (1.f / 1024.f) + EPS); rskv[row] = rsqrtf(s2 * (1.f / 512.f) + EPS); }
        if (C.lane < 32) { kr[(size_t)row * 64 + C.lane] = f2bf(x1[i] * cs[i] - x2[i] * sn[i]); kr[(size_t)row * 64 + 32 + C.lane] = f2bf(x1[i] * sn[i] + x2[i] * cs[i]); }
    }
}
__device__ __forceinline__ void ph_mla_stats(const Ctx& C) {
    const int stride = C.G * 8, nfull = TR / stride, row = C.bid * 8 + C.wave;
    int k = 0;
    for (; k + 4 <= nfull; k += 4) mla_stats_rows<4>(C, row + k * stride, stride);
    for (; k < nfull; ++k) mla_stats_rows<1>(C, row + k * stride, stride);
    for (int j = C.bid; j < TR - nfull * stride; j += C.G)
        if (C.wave == ((j / C.G + C.bid) & 7)) mla_stats_rows<1>(C, nfull * stride + j, stride);
}
__device__ __forceinline__ void ph_mla_ropeq(const Ctx& C) {
    bf16_t* q = (bf16_t*)(C.ws + A_Q);
    const float* tab = (const float*)(C.ws + WS_ROPE);
    for (int row = NCTX + C.bid * 8 + C.wave; row < TR; row += C.G * 8) {
        const int j = C.lane & 31;
        const float cs = tab[(size_t)(row - NCTX) * 64 + j], sn = tab[(size_t)(row - NCTX) * 64 + 32 + j];
#pragma unroll
        for (int it = 0; it < 16; ++it) { const int hh = (C.lane >> 5) + 2 * it;
            bf16_t* pq = q + (size_t)row * 6144 + hh * 192 + 128 + j;
            const float x1 = bf2f(pq[0]), x2 = bf2f(pq[32]);
            pq[0] = f2bf(x1 * cs - x2 * sn); pq[32] = f2bf(x1 * sn + x2 * cs); }
    }
}
template <int IT> __device__ __forceinline__ void ph_mla_attn(const Ctx& C, char* lds_generic) {
    const bf16_t* Q = (const bf16_t*)(C.ws + A_Q); const bf16_t* KV = (const bf16_t*)(C.ws + A_KV); const bf16_t* KR = (const bf16_t*)(C.ws + A_KR);
    const bf16_t* Z = (const bf16_t*)(C.ws + A_Z); bf16_t* OG = (bf16_t*)(C.ws + A_OG);
    for (int u = C.bid; u < 1024 + (IT ? 0 : 32); u += C.G) {
        int head, row0, seq;
        if (u < 1024) { const int r = u >> 8, b = u & 255; head = r * 8 + (b & 7); row0 = NCTX + (b >> 3) * 256; seq = TR; }
        else { head = u - 1024; row0 = 0; seq = NCTX; }
        size_t zo_ = 0; asm volatile("" : "+s"(zo_)); const bf16_t* KRu = KR + zo_;
        att::attn_body(Q + (size_t)row0 * 6144 + head * 192, KV + head * 256, KRu, KV + head * 256 + 128,
                       Z + (size_t)row0 * 4096 + head * 128, OG + (size_t)row0 * 4096 + head * 128, seq, lds_generic, C.wave,
                       u < 1024 ? (const float*)(C.ws + WS_ROPE) + (size_t)(row0 - NCTX) * 64 : nullptr);
    }
}

__device__ __forceinline__ int cperm16(int x) { return 8 * ((x >> 2) & 1) + (x & 3) + 4 * (x >> 3); }
__device__ __forceinline__ void ph_gdn_conv(const Ctx& C, const Params& p) {
    const bf16_t* P = (const bf16_t*)(C.ws + G_QKV);
    bf16_t* qr = (bf16_t*)(C.ws + G_QR); bf16_t* kr = (bf16_t*)(C.ws + G_KR); bf16_t* kt = (bf16_t*)(C.ws + G_KT); bf16_t* vt = (bf16_t*)(C.ws + G_VT);
    const float* cw = p.in[15];
    constexpr int TB = 16;
    for (int w = C.bid * 8 + C.wave; w < (TR / TB) * 128; w += C.G * 8) {
        const int grp = w & 127, t0 = (w >> 7) * TB;
        const int lo = t0 < NCTX ? 0 : NCTX, hi = t0 < NCTX ? NCTX : TR;
        const int c = grp * 128 + 2 * C.lane;
        f32x2 wj[5];
#pragma unroll
        for (int j = 0; j < 5; ++j) wj[j] = *(const f32x2*)(cw + (size_t)j * 16384 + c);
        unsigned raw[TB + 4];
#pragma unroll
        for (int i = 0; i < TB + 4; ++i) { const int r = t0 - 2 + i; raw[i] = (r >= lo && r < hi) ? *(const unsigned*)(P + (size_t)r * 16384 + c) : 0u; }
        float y0[TB], y1[TB], ss[TB];
#pragma unroll
        for (int t = 0; t < TB; ++t) {
            float a0 = 0.f, a1 = 0.f;
#pragma unroll
            for (int j = 0; j < 5; ++j) { a0 += bf_lo(raw[t + j]) * wj[j][0]; a1 += bf_hi(raw[t + j]) * wj[j][1]; }
            y0[t] = silu_f(a0); y1[t] = silu_f(a1); ss[t] = y0[t] * y0[t] + y1[t] * y1[t];
        }
        const int chunk = t0 >> 6, i0 = t0 & 63;
        const int dl = 2 * C.lane, dpos = (dl & ~15) + cperm16(dl & 15);
        if (grp < 64) {
#pragma unroll
            for (int o = 32; o >= 1; o >>= 1)
#pragma unroll
                for (int t = 0; t < TB; ++t) ss[t] += __shfl_xor(ss[t], o);
            const float qs = grp < 32 ? 0.08838834764831845f : 1.f;
#pragma unroll
            for (int t = 0; t < TB; ++t) { const float inv = rsqrtf(ss[t] + EPS) * qs; y0[t] *= inv; y1[t] *= inv; }
            bf16_t* dst = (grp < 32 ? qr + (size_t)(chunk * 32 + grp) * 8192 : kr + (size_t)(chunk * 32 + grp - 32) * 8192) + (size_t)i0 * 128 + dpos;
#pragma unroll
            for (int t = 0; t < TB; ++t) *(unsigned*)(dst + t * 128) = cvt_pk_bf16(y0[t], y1[t]);
        }
        if (grp >= 32) {
            bf16_t* tdst = (grp < 64 ? kt + (size_t)(chunk * 32 + grp - 32) * 8192 : vt + (size_t)(chunk * 64 + grp - 64) * 8192) + (size_t)dl * 64 + i0;
            u32x4 a, b;
            a.x = cvt_pk_bf16(y0[0], y0[1]); a.y = cvt_pk_bf16(y0[2], y0[3]); a.z = cvt_pk_bf16(y0[8], y0[9]); a.w = cvt_pk_bf16(y0[10], y0[11]);
            b.x = cvt_pk_bf16(y0[4], y0[5]); b.y = cvt_pk_bf16(y0[6], y0[7]); b.z = cvt_pk_bf16(y0[12], y0[13]); b.w = cvt_pk_bf16(y0[14], y0[15]);
            *(u32x4*)tdst = a; *(u32x4*)(tdst + 8) = b;
            a.x = cvt_pk_bf16(y1[0], y1[1]); a.y = cvt_pk_bf16(y1[2], y1[3]); a.z = cvt_pk_bf16(y1[8], y1[9]); a.w = cvt_pk_bf16(y1[10], y1[11]);
            b.x = cvt_pk_bf16(y1[4], y1[5]); b.y = cvt_pk_bf16(y1[6], y1[7]); b.z = cvt_pk_bf16(y1[12], y1[13]); b.w = cvt_pk_bf16(y1[14], y1[15]);
            *(u32x4*)(tdst + 64) = a; *(u32x4*)(tdst + 72) = b;
        }
    }
    const float* ab = (const float*)(C.ws + G_AB); float* gate = (float*)(C.ws + G_GATE);
    for (int idx = C.bid * 512 + C.tid; idx < TR * 128; idx += C.G * 512) {
        const int t = idx >> 7, dh = idx & 127, d = dh >> 6, hh = dh & 63;
        const float a = ab[(size_t)t * 256 + dh] + p.in[17][dh], b = ab[(size_t)t * 256 + 128 + dh];
        const float sp = fmaxf(a, 0.f) + log1pf(expf(-fabsf(a)));
        const float g = -expf(p.in[16][dh]) * sp;
        *(f32x2*)(gate + (((size_t)d * TR + t) * 64 + hh) * 2) = (f32x2){g, 1.f / (1.f + expf(-b))};
    }
}

__device__ __forceinline__ int perm16(int x) { return 8 * ((x >> 2) & 1) + (x & 3) + 4 * (x >> 3); }
__device__ __forceinline__ int permP(int X) { return (X & ~15) + perm16(X & 15); }
__device__ __forceinline__ int unperm(int hi, int s) { return 4 * hi + (s & 3) + 8 * (s >> 2); }
__device__ __forceinline__ bf16x8 pack8(float a0, float a1, float a2, float a3, float a4, float a5, float a6, float a7) {
    u32x4 w = {cvt_pk_bf16(a0, a1), cvt_pk_bf16(a2, a3), cvt_pk_bf16(a4, a5), cvt_pk_bf16(a6, a7)}; return *reinterpret_cast<bf16x8*>(&w);
}
#define MFMA32(a, b, c) __builtin_amdgcn_mfma_f32_32x32x16_bf16(a, b, c, 0, 0, 0)

__device__ __forceinline__ void ph_gdn_pre(const Ctx& C, const Params& p) {
    LAS unsigned char* L = C.lds;
    constexpr int O_KR = 0, O_QR = 17408, O_AM = 0, O_KK = 34816, O_QK = 51456, O_KT = 68096, O_VT = 86528, O_GC = 123392;
    LAS float* gc = (LAS float*)(L + O_GC);
    for (int item = C.bid; item < 132 * 32; item += C.G) {
        const int tid_ = tid_opaque(C.wave);
        const int lane = tid_ & 63, r32 = lane & 31, hi = lane >> 5, wv = __builtin_amdgcn_readfirstlane(tid_ >> 6);
        const int c = item >> 5, kh = item & 31, row0 = c * 64;
        size_t zo_ = 0; asm volatile("" : "+s"(zo_)); unsigned char* wsb = C.ws + zo_;
        unsigned char* blobA = wsb + G_BLOBA + (size_t)(c * 32 + kh) * BLOBA_SZ;
        {
            const bf16_t* P = (const bf16_t*)(wsb + G_QKV); const float* cw = p.in[15];
#pragma unroll 1
            for (int rep = 0; rep < 2; ++rep) {
                const int T_ = wv + 8 * rep, hsel = T_ & 3, tbk = T_ >> 2;
                const int ch0 = hsel == 0 ? kh * 128 : (hsel == 1 ? 4096 + kh * 128 : 8192 + (2 * kh + hsel - 2) * 128);
                const int cch = ch0 + 2 * lane, t0 = row0 + 16 * tbk;
                const int lo = t0 < NCTX ? 0 : NCTX, hi_ = t0 < NCTX ? NCTX : TR;
                f32x2 wj[5];
#pragma unroll
                for (int j = 0; j < 5; ++j) wj[j] = *(const f32x2*)(cw + (size_t)j * 16384 + cch);
                unsigned raw[20];
#pragma unroll
                for (int i = 0; i < 20; ++i) { const int r = t0 - 2 + i; raw[i] = (r >= lo && r < hi_) ? *(const unsigned*)(P + (size_t)r * 16384 + cch) : 0u; }
                float y0[16], y1[16], ss[16];
#pragma unroll
                for (int t = 0; t < 16; ++t) {
                    float a0 = 0.f, a1 = 0.f;
#pragma unroll
                    for (int j = 0; j < 5; ++j) { a0 += bf_lo(raw[t + j]) * wj[j][0]; a1 += bf_hi(raw[t + j]) * wj[j][1]; }
                    y0[t] = silu_f(a0); y1[t] = silu_f(a1); ss[t] = y0[t] * y0[t] + y1[t] * y1[t];
                }
                const int dl = 2 * lane, dpos = (dl & ~15) + cperm16(dl & 15);
                if (hsel < 2) {
#pragma unroll
                    for (int o = 1; o < 64; o <<= 1)
#pragma unroll
                        for (int t = 0; t < 16; ++t) ss[t] += __int_as_float(__builtin_amdgcn_ds_bpermute(((lane ^ o) & 63) << 2, __float_as_int(ss[t])));
                    const float qs = hsel == 0 ? 0.08838834764831845f : 1.f;
#pragma unroll
                    for (int t = 0; t < 16; ++t) { const float inv = rsqrtf(ss[t] + EPS) * qs; y0[t] *= inv; y1[t] *= inv; }
                    LAS unsigned char* dst = L + (hsel == 0 ? O_QR : O_KR) + (16 * tbk) * 272 + dpos * 2;
#pragma unroll
                    for (int t = 0; t < 16; ++t) *(LAS unsigned*)(dst + t * 272) = cvt_pk_bf16(y0[t], y1[t]);
                }
                if (hsel >= 1) {
                    LAS unsigned char* tdst = L + (hsel == 1 ? O_KT : O_VT + (hsel - 2) * 18432) + dl * 144 + 32 * tbk;
                    u32x4 a, b;
                    a.x = cvt_pk_bf16(y0[0], y0[1]); a.y = cvt_pk_bf16(y0[2], y0[3]); a.z = cvt_pk_bf16(y0[8], y0[9]); a.w = cvt_pk_bf16(y0[10], y0[11]);
                    b.x = cvt_pk_bf16(y0[4], y0[5]); b.y = cvt_pk_bf16(y0[6], y0[7]); b.z = cvt_pk_bf16(y0[12], y0[13]); b.w = cvt_pk_bf16(y0[14], y0[15]);
                    *(LAS u32x4*)tdst = a; *(LAS u32x4*)(tdst + 16) = b;
                    a.x = cvt_pk_bf16(y1[0], y1[1]); a.y = cvt_pk_bf16(y1[2], y1[3]); a.z = cvt_pk_bf16(y1[8], y1[9]); a.w = cvt_pk_bf16(y1[10], y1[11]);
                    b.x = cvt_pk_bf16(y1[4], y1[5]); b.y = cvt_pk_bf16(y1[6], y1[7]); b.z = cvt_pk_bf16(y1[12], y1[13]); b.w = cvt_pk_bf16(y1[14], y1[15]);
                    *(LAS u32x4*)(tdst + 144) = a; *(LAS u32x4*)(tdst + 144 + 16) = b;
                }
            }
        }
        __syncthreads();
        {
            const int mat = wv >> 2, ib = (wv >> 1) & 1, jb = wv & 1;
            f32x16 acc = {};
            bf16x8 af[8];
#pragma unroll
            for (int kb = 0; kb < 8; ++kb) {
                af[kb] = *(const LAS bf16x8*)(L + (mat ? O_QR : O_KR) + (32 * ib + r32) * 272 + (16 * kb + 8 * hi) * 2);
                const bf16x8 bfr = *(const LAS bf16x8*)(L + O_KR + (32 * jb + r32) * 272 + (16 * kb + 8 * hi) * 2);
                acc = MFMA32(af[kb], bfr, acc);
            }
            LAS float* dst = (LAS float*)(L + (mat ? O_QK : O_KK));
#pragma unroll
            for (int r = 0; r < 16; ++r) dst[(32 * ib + att::crow(r, hi)) * 65 + 32 * jb + r32] = acc[r];
            if (mat == 1 && jb == 0) {
#pragma unroll
                for (int kb = 0; kb < 8; ++kb) *(bf16x8*)(blobA + ((ib * 8 + kb) * 64 + lane) * 16) = af[kb];
            }
        }
        if (wv < 4) {
            const int dir = wv & 1, vh = 2 * kh + (wv >> 1);
            const float* ab = (const float*)(wsb + G_AB) + (size_t)(row0 + lane) * 256 + dir * 64 + vh;
            const float av_ = ab[0] + p.in[17][dir * 64 + vh], bv_ = ab[128];
            const float sp_ = fmaxf(av_, 0.f) + log1pf(expf(-fabsf(av_)));
            f32x2 gb; gb[0] = -expf(p.in[16][dir * 64 + vh]) * sp_; gb[1] = 1.f / (1.f + expf(-bv_));
            float g = gb[0];
            if (dir == 0) {
#pragma unroll
                for (int o = 1; o < 64; o <<= 1) { const float t = __int_as_float(__builtin_amdgcn_ds_bpermute(((lane - o) & 63) << 2, __float_as_int(g))); if (lane >= o) g += t; }
            } else {
#pragma unroll
                for (int o = 1; o < 64; o <<= 1) { const float t = __int_as_float(__builtin_amdgcn_ds_bpermute(((lane + o) & 63) << 2, __float_as_int(g))); if (lane + o < 64) g += t; }
            }
            gc[wv * 64 + lane] = g; gc[256 + wv * 64 + lane] = gb[1]; gc[512 + wv * 64 + lane] = -gb[1] * __expf(g);
            if (lane == (dir ? 0 : 63)) gc[768 + wv] = g;
        }
        __syncthreads();
        {
            const LAS float* KK = (const LAS float*)(L + O_KK); const LAS float* QK = (const LAS float*)(L + O_QK);
            float aval[32];
#pragma unroll
            for (int k = 0; k < 32; ++k) {
                const int n = tid_ + 512 * k, vi = n >> 12, dir = vi & 1, m = (n >> 6) & 63, i = n & 63;
                const bool valid = dir ? (i < m) : (i > m);
                const float e = __expf(gc[vi * 64 + i] - gc[vi * 64 + m]);
                aval[k] = valid ? gc[256 + vi * 64 + i] * KK[i * 65 + m] * e : 0.f;
            }
#pragma unroll
            for (int k = 0; k < 4; ++k) {
                const int n = tid_ + 512 * k, vi = n >> 9, dir = vi & 1, f = (n >> 6) & 7, ib = f >> 2, tb = f & 3, ln = n & 63, rr = ln & 31, hh = ln >> 5;
                const int i = 32 * ib + rr; const float gi = gc[vi * 64 + i];
                float qv[8];
#pragma unroll
                for (int sI = 0; sI < 8; ++sI) { const int j = 16 * tb + unperm(hh, sI); const bool valid = dir ? (j >= i) : (j <= i);
                    const float e = __expf(gi - gc[vi * 64 + j]); qv[sI] = valid ? QK[i * 65 + j] * e : 0.f; }
                unsigned char* bb = wsb + G_BLOBB + (size_t)(c * 128 + dir * 64 + 2 * kh + (vi >> 1)) * BLOBB_SZ;
                *(bf16x8*)(bb + 16384 + (f * 64 + ln) * 16) = pack8(qv[0], qv[1], qv[2], qv[3], qv[4], qv[5], qv[6], qv[7]);
            }
            if (tid_ < 256) { const int vi = tid_ >> 6, i = tid_ & 63; const float gl = gc[768 + vi], gi = gc[vi * 64 + i];
                float* sc = (float*)(wsb + G_BLOBB + (size_t)(c * 128 + (vi & 1) * 64 + 2 * kh + (vi >> 1)) * BLOBB_SZ + 24576);
                sc[i] = __expf(gi); sc[64 + i] = __expf(gl - gi); if (i == 0) sc[128] = __expf(gl); }
            __syncthreads();
            LAS float* AM = (LAS float*)(L + O_AM);
#pragma unroll
            for (int k = 0; k < 32; ++k) {
                const int n = tid_ + 512 * k, vi = n >> 12, dir = vi & 1, m = (n >> 6) & 63, i = n & 63;
                AM[vi * 4096 + (dir ? m * 64 + i : (63 - m) * 64 + (63 - i))] = -aval[k];
            }
        }
        __syncthreads();
        if (wv < 4) {
            const int dir = wv & 1, vhl = wv >> 1, vh = 2 * kh + vhl;
            const LAS float* AM = (const LAS float*)(L + O_AM) + wv * 4096;
            f32x2 x2[32];
#pragma unroll
            for (int q = 0; q < 32; ++q) x2[q] = (f32x2){0.f, 0.f};
            const int tgt = dir ? lane : 63 - lane;
            f32x4 rowA[8];
#define PRE_ROW_LOAD(dst, i_, c0_) do { _Pragma("unroll") for (int q_ = 0; q_ < 8; ++q_) if ((c0_) + 4 * q_ < (i_)) dst[q_] = *(const LAS f32x4*)(AM + (i_) * 64 + (c0_) + 4 * q_); } while (0)
#define PRE_ROW_FMA(src, i_, c0_) do { _Pragma("unroll") for (int q_ = 0; q_ < 8; ++q_) { const int m_ = (c0_) + 4 * q_; if (m_ < (i_)) { \
                const f32x2 c01_ = {src[q_][0], src[q_][1]}, c23_ = {src[q_][2], src[q_][3]}; a01 = __builtin_elementwise_fma(c01_, x2[m_ >> 1], a01); a23 = __builtin_elementwise_fma(c23_, x2[(m_ >> 1) + 1], a23); } } } while (0)
#pragma clang loop unroll(full)
            for (int i = 0; i < 64; ++i) {
                int tg = tgt; asm volatile("" : "+v"(tg));
                f32x2 a01 = {(i == tg) ? 1.f : 0.f, 0.f}, a23 = {0.f, 0.f};
                if (i > 0) {
                    PRE_ROW_LOAD(rowA, i, 0);
                    __builtin_amdgcn_sched_barrier(0);
                    PRE_ROW_FMA(rowA, i, 0);
                    if (i > 32) {
                        __builtin_amdgcn_sched_barrier(0);
                        PRE_ROW_LOAD(rowA, i, 32);
                        __builtin_amdgcn_sched_barrier(0);
                        PRE_ROW_FMA(rowA, i, 32);
                    }
                }
                x2[i >> 1][i & 1] = (a01[0] + a01[1]) + (a23[0] + a23[1]);
                __builtin_amdgcn_sched_barrier(0);
            }
#undef PRE_ROW_LOAD
#undef PRE_ROW_FMA
#define x(r_) x2[(r_) >> 1][(r_) & 1]
            bf16x8 tp1[2][4], tp2[2][4];
            const LAS float* sb = gc + 256 + wv * 64; const LAS float* se = gc + 512 + wv * 64;
#pragma unroll
            for (int tb = 0; tb < 4; ++tb) {
                float b_[16], e_[16];
#pragma unroll
                for (int q = 0; q < 4; ++q) { const f32x4 bv = *(const LAS f32x4*)(sb + 16 * tb + 4 * q), ev = *(const LAS f32x4*)(se + 16 * tb + 4 * q);
                    b_[4 * q] = bv[0]; b_[4 * q + 1] = bv[1]; b_[4 * q + 2] = bv[2]; b_[4 * q + 3] = bv[3]; e_[4 * q] = ev[0]; e_[4 * q + 1] = ev[1]; e_[4 * q + 2] = ev[2]; e_[4 * q + 3] = ev[3]; }
                float t0[8], t1[8];
#pragma unroll
                for (int sI = 0; sI < 8; ++sI) { t0[sI] = dir ? x(16 * tb + unperm(0, sI)) : x(63 - (16 * tb + unperm(0, sI))); t1[sI] = dir ? x(16 * tb + unperm(1, sI)) : x(63 - (16 * tb + unperm(1, sI))); }
                u32x4 P1, Q1, P2, Q2;
#define PRE_PK(T, SC, H) (u32x4){cvt_pk_bf16(T[0] * SC[unperm(H, 0)], T[1] * SC[unperm(H, 1)]), cvt_pk_bf16(T[2] * SC[unperm(H, 2)], T[3] * SC[unperm(H, 3)]), \
                                  cvt_pk_bf16(T[4] * SC[unperm(H, 4)], T[5] * SC[unperm(H, 5)]), cvt_pk_bf16(T[6] * SC[unperm(H, 6)], T[7] * SC[unperm(H, 7)])}
                P1 = PRE_PK(t0, b_, 0); Q1 = PRE_PK(t1, b_, 1); P2 = PRE_PK(t0, e_, 0); Q2 = PRE_PK(t1, e_, 1);
#undef PRE_PK
                u32x4 f0, f1, g0, g1;
#pragma unroll
                for (int w_ = 0; w_ < 4; ++w_) { auto r1 = __builtin_amdgcn_permlane32_swap(P1[w_], Q1[w_], false, false); f0[w_] = r1[0]; f1[w_] = r1[1];
                    auto r2 = __builtin_amdgcn_permlane32_swap(P2[w_], Q2[w_], false, false); g0[w_] = r2[0]; g1[w_] = r2[1]; }
                tp1[0][tb] = *reinterpret_cast<bf16x8*>(&f0); tp1[1][tb] = *reinterpret_cast<bf16x8*>(&f1);
                tp2[0][tb] = *reinterpret_cast<bf16x8*>(&g0); tp2[1][tb] = *reinterpret_cast<bf16x8*>(&g1);
            }
#undef x
            __builtin_amdgcn_sched_barrier(0);
            unsigned char* ufb = wsb + G_UF + (size_t)(c * 128 + dir * 64 + vh) * UF_SZ;
#pragma unroll
            for (int ib = 0; ib < 2; ++ib)
#pragma unroll
                for (int eb = 0; eb < 4; ++eb) {
                    f32x16 acc = {};
#pragma unroll
                    for (int tb = 0; tb < 4; ++tb) acc = MFMA32(tp1[ib][tb], *(const LAS bf16x8*)(L + O_VT + vhl * 18432 + (32 * eb + r32) * 144 + (16 * tb + 8 * hi) * 2), acc);
                    unsigned char* uf = ufb + ((eb * 2 + ib) * 64 + lane) * 32;
                    *(bf16x8*)uf = pack8(acc[0], acc[1], acc[2], acc[3], acc[4], acc[5], acc[6], acc[7]);
                    *(bf16x8*)(uf + 16) = pack8(acc[8], acc[9], acc[10], acc[11], acc[12], acc[13], acc[14], acc[15]);
                }
            __builtin_amdgcn_sched_barrier(0);
            unsigned char* wf = wsb + G_BLOBB + (size_t)(c * 128 + dir * 64 + vh) * BLOBB_SZ;
#pragma unroll
            for (int db = 0; db < 4; ++db)
#pragma unroll
                for (int ib = 0; ib < 2; ++ib) {
                    f32x16 acc = {};
#pragma unroll
                    for (int tb = 0; tb < 4; ++tb) acc = MFMA32(*(const LAS bf16x8*)(L + O_KT + (32 * db + r32) * 144 + (16 * tb + 8 * hi) * 2), tp2[ib][tb], acc);
                    *(bf16x8*)(wf + ((ib * 8 + 2 * db) * 64 + lane) * 16) = pack8(acc[0], acc[1], acc[2], acc[3], acc[4], acc[5], acc[6], acc[7]);
                    *(bf16x8*)(wf + ((ib * 8 + 2 * db + 1) * 64 + lane) * 16) = pack8(acc[8], acc[9], acc[10], acc[11], acc[12], acc[13], acc[14], acc[15]);
                }
        } else {
#pragma unroll
            for (int q = 0; q < 4; ++q) { const int f = (wv - 4) * 4 + q, db = f >> 2, tb = f & 3;
                const bf16x8 kf = *(const LAS bf16x8*)(L + O_KT + (32 * db + r32) * 144 + (16 * tb + 8 * hi) * 2);
                *(bf16x8*)(blobA + 16384 + (f * 64 + lane) * 16) = kf; }
        }
        __syncthreads();
    }
}

__device__ __forceinline__ void ph_gdn_scan2(const Ctx& C) {
    constexpr int NS = 132, BUF = 58368;
    bf16_t* go = (bf16_t*)(C.ws + G_O);
    LAS unsigned char* L = C.lds;
    const int lane = C.lane, r32 = lane & 31, hi = lane >> 5, wv = C.wave;
    for (int u = C.bid; u < 128; u += C.G) {
        const int x = u & 7, t = u >> 3, kh = x * 4 + (t >> 2), mem = t & 3, vh = 2 * kh + (mem & 1), dir = mem >> 1;
        const int v = dir * 64 + vh, eb = wv & 3;
#define SC2_CHUNK(s) (dir == 0 ? (s) : ((s) < 4 ? 3 - (s) : 135 - (s)))
#define SC2_DMA(s, bufi) do { if (wv >= 4) { const int c_ = SC2_CHUNK(s); const int ht_ = C.tid - 256; \
        const unsigned char* ga_ = C.ws + G_BLOBA + (size_t)(c_ * 32 + kh) * BLOBA_SZ; const unsigned char* gb_ = C.ws + G_BLOBB + (size_t)(c_ * 128 + v) * BLOBB_SZ; \
        LAS unsigned char* lb_ = L + (bufi) * BUF + (wv - 4) * 1024; \
        _Pragma("unroll") for (int k_ = 0; k_ < 8; ++k_) __builtin_amdgcn_global_load_lds((const unsigned*)(ga_ + (ht_ + 256 * k_) * 16), (LAS unsigned*)(lb_ + k_ * 4096), 16, 0, 0); \
        _Pragma("unroll") for (int k_ = 0; k_ < 6; ++k_) __builtin_amdgcn_global_load_lds((const unsigned*)(gb_ + (ht_ + 256 * k_) * 16), (LAS unsigned*)(lb_ + 32768 + k_ * 4096), 16, 0, 0); \
        if (ht_ < 64) __builtin_amdgcn_global_load_lds((const unsigned*)(gb_ + (ht_ + 1536) * 16), (LAS unsigned*)(lb_ + 32768 + 24576), 16, 0, 0); } } while (0)
        f32x16 S[4]; bf16x8 Sb[8];
#pragma unroll
        for (int i = 0; i < 4; ++i) S[i] = f32x16{};
#pragma unroll
        for (int i = 0; i < 8; ++i) Sb[i] = bf16x8{};
        __syncthreads();
        SC2_DMA(0, 0);
        u32x4 uraw[2][2], unext[2][2];
#define SC2_ULOAD(dst, s) do { const unsigned char* uf_ = C.ws + G_UF + (size_t)(SC2_CHUNK(s) * 128 + v) * UF_SZ + (eb * 2 * 64 + lane) * 32; \
        _Pragma("unroll") for (int ib_ = 0; ib_ < 2; ++ib_) { dst[ib_][0] = *(const u32x4*)(uf_ + ib_ * 2048); dst[ib_][1] = *(const u32x4*)(uf_ + ib_ * 2048 + 16); } } while (0)
        if (wv >= 4) {
            for (int s = 0; s < NS; ++s) {
                asm volatile("s_waitcnt vmcnt(0)" ::: "memory");
                __syncthreads();
                if (s + 1 < NS) SC2_DMA(s + 1, (s + 1) & 1);
            }
        } else {
        SC2_ULOAD(unext, 0);
        for (int s = 0; s < NS; ++s) {
            __syncthreads();
            const int c = SC2_CHUNK(s);
            {
#pragma unroll
                for (int ib = 0; ib < 2; ++ib) { uraw[ib][0] = unext[ib][0]; uraw[ib][1] = unext[ib][1]; }
                if (s + 1 < NS) SC2_ULOAD(unext, s + 1);
            }
            {
                const LAS unsigned char* B = L + (s & 1) * BUF;
                const LAS unsigned char* fQ = B + lane * 16; const LAS unsigned char* fK = B + 16384 + lane * 16;
                const LAS unsigned char* fW = B + 32768 + lane * 16; const LAS unsigned char* fD = B + 49152 + lane * 16;
                const LAS float* sc = (const LAS float*)(B + 57344);
                f32x16 ao[2], av[2];
#pragma unroll
                for (int ib = 0; ib < 2; ++ib) { ao[ib] = f32x16{};
#pragma unroll
                    for (int kb = 0; kb < 8; ++kb) ao[ib] = MFMA32(*(const LAS bf16x8*)(fQ + (ib * 8 + kb) * 1024), Sb[kb], ao[ib]); }
#pragma unroll
                for (int ib = 0; ib < 2; ++ib) {
#pragma unroll
                    for (int w2 = 0; w2 < 2; ++w2) { const u32x4 uw = uraw[ib][w2];
                        av[ib][8 * w2 + 0] = bf_lo(uw.x); av[ib][8 * w2 + 1] = bf_hi(uw.x); av[ib][8 * w2 + 2] = bf_lo(uw.y); av[ib][8 * w2 + 3] = bf_hi(uw.y);
                        av[ib][8 * w2 + 4] = bf_lo(uw.z); av[ib][8 * w2 + 5] = bf_hi(uw.z); av[ib][8 * w2 + 6] = bf_lo(uw.w); av[ib][8 * w2 + 7] = bf_hi(uw.w); }
#pragma unroll
                    for (int kb = 0; kb < 8; ++kb) av[ib] = MFMA32(*(const LAS bf16x8*)(fW + (ib * 8 + kb) * 1024), Sb[kb], av[ib]); }
                bf16x8 vb[4], vb2[4];
#pragma unroll
                for (int ib = 0; ib < 2; ++ib)
#pragma unroll
                    for (int h = 0; h < 2; ++h) {
                        const f32x4 d0 = *(const LAS f32x4*)(sc + 64 + 32 * ib + 16 * h + 4 * hi), d1 = *(const LAS f32x4*)(sc + 64 + 32 * ib + 16 * h + 8 + 4 * hi);
                        const f32x4 e0 = *(const LAS f32x4*)(sc + 32 * ib + 16 * h + 4 * hi), e1 = *(const LAS f32x4*)(sc + 32 * ib + 16 * h + 8 + 4 * hi);
                        const int r0 = 8 * h;
                        vb[2 * ib + h] = pack8(av[ib][r0], av[ib][r0 + 1], av[ib][r0 + 2], av[ib][r0 + 3], av[ib][r0 + 4], av[ib][r0 + 5], av[ib][r0 + 6], av[ib][r0 + 7]);
                        vb2[2 * ib + h] = pack8(av[ib][r0] * d0[0], av[ib][r0 + 1] * d0[1], av[ib][r0 + 2] * d0[2], av[ib][r0 + 3] * d0[3],
                                                av[ib][r0 + 4] * d1[0], av[ib][r0 + 5] * d1[1], av[ib][r0 + 6] * d1[2], av[ib][r0 + 7] * d1[3]);
#pragma unroll
                        for (int q = 0; q < 4; ++q) { ao[ib][r0 + q] *= e0[q]; ao[ib][r0 + 4 + q] *= e1[q]; }
                    }
#pragma unroll
                for (int ib = 0; ib < 2; ++ib) {
#pragma unroll
                    for (int tb = 0; tb < 4; ++tb) ao[ib] = MFMA32(*(const LAS bf16x8*)(fD + (ib * 4 + tb) * 1024), vb[tb], ao[ib]);
                    const unsigned ooff = (unsigned)(((dir * TR + c * 64 + 32 * ib + 4 * hi) * 8192 + vh * 128 + 32 * eb + r32));
#pragma unroll
                    for (int r = 0; r < 16; ++r) *(bf16_t*)((unsigned char*)go + (2u * ooff + (unsigned)(((r & 3) + 8 * (r >> 2)) * 16384))) = f2bf(ao[ib][r]);
                }
                const float gl = sc[128];
#pragma unroll
                for (int db = 0; db < 4; ++db) {
#pragma unroll
                    for (int r = 0; r < 16; ++r) S[db][r] *= gl;
#pragma unroll
                    for (int tb = 0; tb < 4; ++tb) S[db] = MFMA32(*(const LAS bf16x8*)(fK + (db * 4 + tb) * 1024), vb2[tb], S[db]);
                    Sb[2 * db] = pack8(S[db][0], S[db][1], S[db][2], S[db][3], S[db][4], S[db][5], S[db][6], S[db][7]);
                    Sb[2 * db + 1] = pack8(S[db][8], S[db][9], S[db][10], S[db][11], S[db][12], S[db][13], S[db][14], S[db][15]);
                }
            }
        }
        }
        asm volatile("s_waitcnt vmcnt(0)" ::: "memory");
        __syncthreads();
#undef SC2_CHUNK
#undef SC2_DMA
#undef SC2_ULOAD
    }
}

__device__ __forceinline__ void ph_gdn_post(const Ctx& C, const Params& p) {
    const bf16_t* go = (const bf16_t*)(C.ws + G_O); const bf16_t* z = (const bf16_t*)(C.ws + G_Z); bf16_t* og = (bf16_t*)(C.ws + G_OG);
    const int sub = C.lane >> 4, c8 = (C.lane & 15) * 8;
    const f32x4 g0 = *(const f32x4*)(p.in[18] + c8), g1 = *(const f32x4*)(p.in[18] + c8 + 4);
    constexpr int K = 4;
    for (int idx0 = (C.bid * 8 + C.wave) * (4 * K); idx0 < TR * 64; idx0 += C.G * 8 * 4 * K) {
        u32x4 a[K], b[K], zz[K]; float o[K][8], ss[K];
#pragma unroll
        for (int k = 0; k < K; ++k) { const size_t off = (size_t)(idx0 + 4 * k + sub) * 128 + c8;
            a[k] = *(const u32x4*)(go + off); b[k] = *(const u32x4*)(go + (size_t)TR * 8192 + off); zz[k] = *(const u32x4*)(z + off); }
#pragma unroll
        for (int k = 0; k < K; ++k) {
            o[k][0] = bf_lo(a[k].x) + bf_lo(b[k].x); o[k][1] = bf_hi(a[k].x) + bf_hi(b[k].x); o[k][2] = bf_lo(a[k].y) + bf_lo(b[k].y); o[k][3] = bf_hi(a[k].y) + bf_hi(b[k].y);
            o[k][4] = bf_lo(a[k].z) + bf_lo(b[k].z); o[k][5] = bf_hi(a[k].z) + bf_hi(b[k].z); o[k][6] = bf_lo(a[k].w) + bf_lo(b[k].w); o[k][7] = bf_hi(a[k].w) + bf_hi(b[k].w);
            float t = 0.f;
#pragma unroll
            for (int j = 0; j < 8; ++j) t += o[k][j] * o[k][j];
            ss[k] = t; }
#pragma unroll
        for (int sh = 8; sh >= 1; sh >>= 1)
#pragma unroll
            for (int k = 0; k < K; ++k) ss[k] += __shfl_xor(ss[k], sh);
#pragma unroll
        for (int k = 0; k < K; ++k) { const float rs = rsqrtf(ss[k] * (1.f / 128.f) + EPS);
            u32x4 w;
            w.x = cvt_pk_bf16(o[k][0] * rs * g0[0] * silu_f(bf_lo(zz[k].x)), o[k][1] * rs * g0[1] * silu_f(bf_hi(zz[k].x)));
            w.y = cvt_pk_bf16(o[k][2] * rs * g0[2] * silu_f(bf_lo(zz[k].y)), o[k][3] * rs * g0[3] * silu_f(bf_hi(zz[k].y)));
            w.z = cvt_pk_bf16(o[k][4] * rs * g1[0] * silu_f(bf_lo(zz[k].z)), o[k][5] * rs * g1[1] * silu_f(bf_hi(zz[k].z)));
            w.w = cvt_pk_bf16(o[k][6] * rs * g1[2] * silu_f(bf_lo(zz[k].w)), o[k][7] * rs * g1[3] * silu_f(bf_hi(zz[k].w)));
            *(u32x4*)(og + (size_t)(idx0 + 4 * k + sub) * 128 + c8) = w; }
    }
}

template <int R>
__device__ __forceinline__ void pool_window_block(const bf16_t* __restrict__ u, bf16_t* __restrict__ m, int t0, int c) {
    const int slo = t0 < NCTX ? 0 : NCTX, shi = t0 < NCTX ? NCTX : TR;
    f32x4 rowv[16 + 2 * R];
    { u32x2 rw[16 + 2 * R];
#pragma unroll
      for (int i = 0; i < 16 + 2 * R; ++i) { const int r = t0 - R + i; rw[i] = (r >= slo && r < shi) ? *(const u32x2*)(u + (size_t)r * DM + c) : (u32x2){0u, 0u}; }
#pragma unroll
      for (int i = 0; i < 16 + 2 * R; ++i) rowv[i] = (f32x4){bf_lo(rw[i].x), bf_hi(rw[i].x), bf_lo(rw[i].y), bf_hi(rw[i].y)}; }
#pragma unroll
    for (int j = 0; j < 16; ++j) {
        const int t = t0 + j, lo = (t - R) > slo ? (t - R) : slo, hi = (t + R + 1) < shi ? (t + R + 1) : shi;
        f32x4 sum = rowv[j];
#pragma unroll
        for (int k = 1; k < 2 * R + 1; ++k) sum += rowv[j + k];
        const f32x4 v = sum * (1.f / (float)(hi - lo)) - rowv[j + R];
        u32x2 w; w.x = cvt_pk_bf16(v[0], v[1]); w.y = cvt_pk_bf16(v[2], v[3]);
        *(u32x2*)(m + (size_t)t * DM + c) = w;
    }
}
__device__ __forceinline__ void ph_pool_window(const Ctx& C) {
    const bf16_t* u = (const bf16_t*)(C.ws + P_U); bf16_t* m = (bf16_t*)(C.ws + P_M);
    constexpr int total = (TR / 16) * 1024;
    const int per = C.G * 512, nfull = total / per;
    for (int it = 0; it <= nfull; ++it) {
        int idx;
        if (it < nfull) idx = it * per + C.bid * 512 + C.tid;
        else {
            const int j = C.bid;
            const int nl = (total - nfull * per) / 64;
            const int jj = j + C.G * ((C.wave - C.bid) & 7);
            if (jj >= nl) break;
            idx = nfull * per + jj * 64 + C.lane;
        }
        const int t0 = (idx >> 10) * 16, c4 = idx & 1023, c = c4 * 4, g = c4 >> 8;
        if (g == 0) pool_window_block<1>(u, m, t0, c);
        else if (g == 1) pool_window_block<2>(u, m, t0, c);
        else if (g == 2) pool_window_block<4>(u, m, t0, c);
        else pool_window_block<8>(u, m, t0, c);
    }
}

constexpr int N_PHASES = 2 + 6 + 6 + 5 + 6;
#ifndef SITE_MASK
#define SITE_MASK 0xffffffffu
#endif
#ifndef REPEAT_MASK
#define REPEAT_MASK 0u
#endif
#define PH_ON(k) (((SITE_MASK >> ((k) & 31)) & 1u) && lo <= (k) && (k) < hi)
#define PH_REP(k) ((((REPEAT_MASK) >> ((k) & 31)) & 1u) != 0u)
#define PHASE(k, ...) if (PH_ON(k)) { C.tid = tid_opaque(C.wave); C.lane = C.tid & 63; { size_t z_ = 0; asm volatile("" : "+s"(z_)); C.ws = p.ws + z_; } ws = C.ws; __VA_ARGS__ } if (PH_REP(k)) { if (PH_ON(k)) { __VA_ARGS__ } } if (lo <= (k) && (k) + 1 < hi) xcd_barrier(bar);

using SegY = pg8::SegCfg<WS_Y, 4096, 0>;

template <int IT, int PH0>
__device__ __forceinline__ void mla_layer(Ctx& C, const Params& p, const int lo, const int hi, const XcdBarrier& bar, char* lds_generic) {
    unsigned char* ws = C.ws;
    PHASE(PH0 + 0,
        using G = pg8::GC<WS_H, WS_W_MLA_IN + IT * SZ_W_MLA_IN, MLA_NP, 4096, 4096, 4096, 0>;
        using SG = pg8::SegCfg<A_CQ, 1024, 0, 4, A_CKV, 512, 0, 6, A_Z, 4096, 0, 22, A_KRRAW, 256, 1>;
        pg8::EpiStore<SG, false> E{ws, nullptr};
        pg8::gemm_phase<G>(C.lds, ws, C.G, C.bid, E, C.wave);
    )
    PHASE(PH0 + 1, ph_mla_stats(C); )
    PHASE(PH0 + 2,
        { using G = pg8::GC<A_CQ, WS_W_QUP + IT * SZ_W_QUP, 6144, 1024, 1024, 1024, 0, IT>;
          pg8::EpiStore<pg8::SegCfg<A_Q, 6144, 0>, true> E{ws, (const float*)(ws + A_RSQ)};
          pg8::gemm_phase<G>(C.lds, ws, C.G, C.bid, E, C.wave); }
        { using G = pg8::GC<A_CKV, WS_W_KVUP + IT * SZ_W_KVUP, 8192, 512, 512, 512, 0>;
          pg8::EpiStore<pg8::SegCfg<A_KV, 8192, 0>, true> E{ws, (const float*)(ws + A_RSKV)};
          pg8::gemm_phase<G>(C.lds, ws, C.G, C.G == 256 ? (C.bid ^ 128) : C.bid, E, C.wave); }
    )
    PHASE(PH0 + 3, ph_mla_attn<IT>(C, lds_generic); )
    PHASE(PH0 + 4,
        using G = pg8::GC<A_OG, WS_W_MLA_OUT + IT * SZ_W_MLA_OUT, 4096, 4096, 4096, 4096, 0, 1>;
        pg8::EpiStore<SegY, false> E{ws, nullptr};
        pg8::gemm_phase<G>(C.lds, ws, C.G, C.bid, E, C.wave);
        if (IT == 0) {
            using G2 = pg8::GC<A_OG, WS_W_MLA_OUT + IT * SZ_W_MLA_OUT, 4096, 4096, 4096, 4096, 0, 0, 1, YPARTS>;
            pg8::EpiPart<YPARTS, 4096> E2{(float*)(ws + WS_YPART)};
            pg8::gemm_phase<G2>(C.lds, ws, C.G, C.bid, E2, C.wave); }
    )
    PHASE(PH0 + 5, if (IT == 0) ph_rows<1>(C, p, 0, 1); else ph_rows<2>(C, p, 3, 3); )
}

__global__ void __launch_bounds__(512, 2) mega(Params p) {
    extern __shared__ __attribute__((aligned(16))) unsigned char shm[];
    Ctx C; C.wave = __builtin_amdgcn_readfirstlane(threadIdx.x >> 6); C.tid = tid_opaque(C.wave); C.lane = C.tid & 63; C.bid = blockIdx.x; C.G = gridDim.x;
    C.ws = p.ws; C.lds = (LAS unsigned char*)shm;
    volatile LAS unsigned* misc = (volatile LAS unsigned*)(C.lds + LDS_STAGE);
    if (C.tid < 4) misc[C.tid] = 0u;
    __syncthreads();
    const int lo = p.ph_lo, hi = p.ph_hi;
    XcdBarrier bar; bar.bar = (unsigned*)(p.ws + WS_BAR); bar.x = 0; bar.st = misc; bar.w = (unsigned)C.wave;
    if (hi - lo > 1) bar = xcd_barrier_post((unsigned*)(p.ws + WS_BAR), misc, (unsigned)C.wave);
    unsigned char* ws = p.ws;

    PHASE(0, ph_adaln(C, p, 0, C.G == 256 ? 144 : 192, 0); ph_wconv<0>(C, p, 0, p.ntiles_early); ph_rope_table(C); )
    PHASE(1, ph_rows<0>(C, p, 0, 0); )
    mla_layer<0, 2>(C, p, lo, hi, bar, (char*)shm);
    PHASE(8,
        using G = pg8::GC<WS_H, WS_W_GDN_IN, GDN_IN, 4096, 4096, 4096, 0, 0, TR / 256, 0, 1>;
        using SG = pg8::SegCfg<G_QKV, 16384, 0, 64, G_AB, 256, 1, 65, G_Z, 8192, 0>;
        pg8::EpiStore<SG, false, true> E{ws, nullptr};
        pg8::gemm_phase<G>(C.lds, ws, C.G, C.bid, E, C.wave);
        if (C.G == 256) { C.tid = tid_opaque(C.wave); C.lane = C.tid & 63; ph_wconv<2>(C, p, p.ntiles_early, p.ntiles_early + p.pad_); }
    )
    PHASE(9, ph_gdn_pre(C, p); )
    PHASE(10, ph_gdn_scan2(C); C.tid = tid_opaque(C.wave); C.lane = C.tid & 63; if (C.G == 256) ph_adaln(C, p, 144, 192, 128); ph_wconv<1>(C, p, p.ntiles_early + (C.G == 256 ? p.pad_ : 0), C.G == 256 ? p.ntiles_l3 : p.ntiles); )
    PHASE(11, ph_gdn_post(C, p); )
    PHASE(12,
        using G = pg8::GC<G_OG, WS_W_GDN_OUT, 4096, 8192, 8192, 8192, 0, 1>;
        pg8::EpiStore<SegY, false> E{ws, nullptr};
        pg8::gemm_phase<G>(C.lds, ws, C.G, C.bid, E, C.wave);
        using G2 = pg8::GC<G_OG, WS_W_GDN_OUT, 4096, 8192, 8192, 8192, 0, 0, 1, YPARTS>;
        pg8::EpiPart<YPARTS, 4096> E2{(float*)(ws + WS_YPART)};
        pg8::gemm_phase<G2>(C.lds, ws, C.G, C.bid, E2, C.wave);
    )
    PHASE(13, ph_rows<1>(C, p, 1, 2); )
    PHASE(14,
        using G = pg8::GC<WS_H, WS_W_POOL_IN, 8192, 4096, 4096, 4096, 0>;
        using SG = pg8::SegCfg<P_U, 4096, 0, 16, P_Z, 4096, 0>;
        pg8::EpiStore<SG, false> E{ws, nullptr};
        pg8::gemm_phase<G>(C.lds, ws, C.G, C.bid, E, C.wave);
        if (C.G == 256) { C.tid = tid_opaque(C.wave); C.lane = C.tid & 63; ph_wconv<3>(C, p, p.ntiles_l3, p.ntiles); }
    )
    PHASE(15, ph_pool_window(C); )
    PHASE(16,
        using G = pg8::GC<P_M, WS_W_POOL_GRP, 4096, 1024, 4096, 1024, 4>;
        pg8::EpiPool E{(bf16_t*)(ws + P_G), (const bf16_t*)(ws + P_Z), p.in[22], 4096};
        pg8::gemm_phase<G>(C.lds, ws, C.G, C.bid, E, C.wave);
    )
    PHASE(17,
        using G = pg8::GC<P_G, WS_W_POOL_OUT, 4096, 4096, 4096, 4096, 0, 1>;
        pg8::EpiStore<SegY, false> E{ws, nullptr};
        pg8::gemm_phase<G>(C.lds, ws, C.G, C.bid, E, C.wave);
        using G2 = pg8::GC<P_G, WS_W_POOL_OUT, 4096, 4096, 4096, 4096, 0, 0, 1, YPARTS>;
        pg8::EpiPart<YPARTS, 4096> E2{(float*)(ws + WS_YPART)};
        pg8::gemm_phase<G2>(C.lds, ws, C.G, C.bid, E2, C.wave);
    )
    PHASE(18, ph_rows<1>(C, p, 2, 3); )
    mla_layer<1, 19>(C, p, lo, hi, bar, (char*)shm);
}

static int add_job(Params& p, int& nj, int& tiles, const float* src, const float* scale, bf16_t* dst, int ld_src, int K, int ncols) {
    TJob& j = p.jobs[nj++]; j.src = src; j.scale = scale; j.dst = dst; j.ld_src = ld_src; j.K = K; j.ncols = ncols; j.tile0 = tiles;
    tiles += (ncols / 64) * (K / 128); return nj;
}

extern "C" void kernel_launch(void* const* d_in, const int* in_sizes, int n_in, void* d_out, int out_size, void* d_ws, size_t ws_size, hipStream_t stream) {
    static int grid = 0;
    if (grid == 0) {
        if (n_in != 24 || out_size != NLAT * DM || ws_size < WS_END) { fprintf(stderr, "kernel_launch: unexpected shapes (n_in %d out %d ws %zu need %zu)\n", n_in, out_size, ws_size, (size_t)WS_END); grid = -1; return; }
        int dev = 0, cus = 0, per_cu = 0;
        if (hipGetDevice(&dev) != hipSuccess || hipDeviceGetAttribute(&cus, hipDeviceAttributeMultiprocessorCount, dev) != hipSuccess) { grid = -1; return; }
        if (hipFuncSetAttribute((const void*)mega, hipFuncAttributeMaxDynamicSharedMemorySize, LDS_BYTES) != hipSuccess) { fprintf(stderr, "kernel_launch: hipFuncSetAttribute failed\n"); grid = -1; return; }
        if (hipOccupancyMaxActiveBlocksPerMultiprocessor(&per_cu, (const void*)mega, 512, LDS_BYTES) != hipSuccess || per_cu < 1) fprintf(stderr, "kernel_launch: occupancy query reports %d\n", per_cu);
        (void)hipGetLastError();
        grid = cus;
    }
    if (grid < 0) return;
    (void)hipMemsetAsync((char*)d_ws + WS_BAR, 0, 16384, stream);
    Params p{};
    for (int i = 0; i < 24; ++i) p.in[i] = (const float*)d_in[i];
    p.out = (float*)d_out; p.ws = (unsigned char*)d_ws;
    unsigned char* ws = (unsigned char*)d_ws;
    int nj = 0, tiles = 0;
    auto mla_jobs = [&](int j) {
        const float* win = p.in[8] + (size_t)j * 4096 * 5696; bf16_t* d = (bf16_t*)(ws + WS_W_MLA_IN + j * SZ_W_MLA_IN);
        add_job(p, nj, tiles, win, nullptr, d, 5696, 4096, 1536);
        add_job(p, nj, tiles, win + 1600, nullptr, d + (size_t)1536 * 4096, 5696, 4096, 4096);
        add_job(p, nj, tiles, win + 1536, nullptr, d + (size_t)5632 * 4096, 5696, 4096, 64);
        add_job(p, nj, tiles, nullptr, nullptr, d + (size_t)5696 * 4096, 5696, 4096, 192);
        add_job(p, nj, tiles, p.in[10] + (size_t)j * 1024 * 6144, p.in[9] + j * 1024, (bf16_t*)(ws + WS_W_QUP + j * SZ_W_QUP), 6144, 1024, 6144);
        add_job(p, nj, tiles, p.in[12] + (size_t)j * 512 * 8192, p.in[11] + j * 512, (bf16_t*)(ws + WS_W_KVUP + j * SZ_W_KVUP), 8192, 512, 8192);
        add_job(p, nj, tiles, p.in[13] + (size_t)j * 4096 * 4096, nullptr, (bf16_t*)(ws + WS_W_MLA_OUT + j * SZ_W_MLA_OUT), 4096, 4096, 4096);
    };
    mla_jobs(0);
    add_job(p, nj, tiles, p.in[14], nullptr, (bf16_t*)(ws + WS_W_GDN_IN), GDN_IN, 4096, GDN_IN);
    p.ntiles_early = tiles; const int tiles_early_ = tiles;
    add_job(p, nj, tiles, p.in[19], nullptr, (bf16_t*)(ws + WS_W_GDN_OUT), 4096, 8192, 4096);
    const int tiles_gout_ = tiles;
    add_job(p, nj, tiles, p.in[20], nullptr, (bf16_t*)(ws + WS_W_POOL_IN), 8192, 4096, 8192);
    for (int g = 0; g < 4; ++g) add_job(p, nj, tiles, p.in[21] + (size_t)g * 1024 * 1024, nullptr, (bf16_t*)(ws + WS_W_POOL_GRP) + (size_t)g * 1024 * 1024, 1024, 1024, 1024);
    add_job(p, nj, tiles, p.in[23], nullptr, (bf16_t*)(ws + WS_W_POOL_OUT), 4096, 4096, 4096);
    const int tiles_l3_ = tiles;
    mla_jobs(1);
    p.njobs = nj; p.ntiles = tiles; p.pad2_ = 0;
    p.pad_ = tiles_gout_ - tiles_early_;
    p.ntiles_l3 = tiles - 3808 > tiles_l3_ ? tiles - 3808 : tiles_l3_;
#if N_LAUNCHES == 1
    p.ph_lo = 0; p.ph_hi = N_PHASES;
    hipLaunchKernelGGL(mega, dim3(grid), dim3(512), LDS_BYTES, stream, p);
#else
    for (int k = 0; k < N_PHASES; ++k) { p.ph_lo = k; p.ph_hi = k + 1; hipLaunchKernelGGL(mega, dim3(grid), dim3(512), LDS_BYTES, stream, p); }
#endif
    const hipError_t le = hipPeekAtLastError();
    if (le != hipSuccess) fprintf(stderr, "kernel_launch: launch failed: %s\n", hipGetErrorName(le));
}
```

```cpp
#include <hip/hip_runtime.h>
#include <stdint.h>
#include <stdio.h>

#ifndef N_LAUNCHES
#define N_LAUNCHES 1
#endif

typedef unsigned short bf16_t;
typedef short bf16x8 __attribute__((ext_vector_type(8)));
typedef short s16x4 __attribute__((ext_vector_type(4)));
typedef float f32x2 __attribute__((ext_vector_type(2)));
typedef float f32x4 __attribute__((ext_vector_type(4)));
typedef float f32x16 __attribute__((ext_vector_type(16)));
typedef unsigned u32x2 __attribute__((ext_vector_type(2)));
typedef unsigned u32x4 __attribute__((ext_vector_type(4)));
#define LAS __attribute__((address_space(3)))

constexpr int TR = 8448;
constexpr int NCTX = 256, NLAT = 8192, DM = 4096;
constexpr float EPS = 1e-6f;
constexpr int MLA_NP = 5888;
constexpr int GDN_IN = 24832;

constexpr size_t al256(size_t x) { return (x + 255) & ~(size_t)255; }
constexpr size_t WS_BAR = 0;
constexpr size_t WS_MOD = 16384;
constexpr size_t WS_ROPE = WS_MOD + al256(4 * 2 * 12288 * 4);
constexpr size_t WS_XC = WS_ROPE + al256((size_t)8192 * 64 * 4);
constexpr size_t WS_H = WS_XC + al256((size_t)256 * 4096 * 4);
constexpr size_t WS_Y = WS_H + al256((size_t)TR * 4096 * 2);
constexpr size_t WS_W_MLA_IN = WS_Y + al256((size_t)TR * 4096 * 4);
constexpr size_t SZ_W_MLA_IN = (size_t)MLA_NP * 4096 * 2;
constexpr size_t WS_W_QUP = WS_W_MLA_IN + 2 * SZ_W_MLA_IN;
constexpr size_t SZ_W_QUP = (size_t)6144 * 1024 * 2;
constexpr size_t WS_W_KVUP = WS_W_QUP + 2 * SZ_W_QUP;
constexpr size_t SZ_W_KVUP = (size_t)8192 * 512 * 2;
constexpr size_t WS_W_MLA_OUT = WS_W_KVUP + 2 * SZ_W_KVUP;
constexpr size_t SZ_W_MLA_OUT = (size_t)4096 * 4096 * 2;
constexpr size_t WS_W_GDN_IN = WS_W_MLA_OUT + 2 * SZ_W_MLA_OUT;
constexpr size_t WS_W_GDN_OUT = WS_W_GDN_IN + (size_t)GDN_IN * 4096 * 2;
constexpr size_t WS_W_POOL_IN = WS_W_GDN_OUT + (size_t)4096 * 8192 * 2;
constexpr size_t WS_W_POOL_GRP = WS_W_POOL_IN + (size_t)8192 * 4096 * 2;
constexpr size_t WS_W_POOL_OUT = WS_W_POOL_GRP + (size_t)4096 * 1024 * 2;
constexpr size_t WS_ACT = WS_W_POOL_OUT + (size_t)4096 * 4096 * 2;
constexpr size_t A_CQ = WS_ACT;
constexpr size_t A_CKV = A_CQ + (size_t)TR * 1024 * 2;
constexpr size_t A_Z = A_CKV + (size_t)TR * 512 * 2;
constexpr size_t A_KRRAW = A_Z + (size_t)TR * 4096 * 2;
constexpr size_t A_KR = A_KRRAW + (size_t)TR * 256 * 4;
constexpr size_t A_RSQ = A_KR + (size_t)TR * 64 * 2;
constexpr size_t A_RSKV = A_RSQ + al256((size_t)TR * 4);
constexpr size_t A_Q = A_RSKV + al256((size_t)TR * 4);
constexpr size_t A_KV = A_Q + (size_t)TR * 6144 * 2;
constexpr size_t A_OG = A_KV + (size_t)TR * 8192 * 2;
constexpr size_t A_MLA_END = A_OG + (size_t)TR * 4096 * 2;
constexpr size_t G_QKV = WS_ACT;
constexpr size_t G_AB = G_QKV + (size_t)TR * 16384 * 2;
constexpr size_t G_Z = G_AB + (size_t)TR * 256 * 4;
constexpr size_t G_QR = G_Z + (size_t)TR * 8192 * 2;
constexpr size_t G_KR = G_QR + (size_t)TR * 4096 * 2;
constexpr size_t G_KT = G_KR + (size_t)TR * 4096 * 2;
constexpr size_t G_VT = G_KT + (size_t)TR * 4096 * 2;
constexpr size_t G_GATE = G_VT + (size_t)TR * 8192 * 2;
constexpr size_t G_O = G_GATE + (size_t)2 * TR * 64 * 2 * 4;
constexpr size_t G_OG = G_O + (size_t)2 * TR * 8192 * 2;
constexpr size_t G_BLOBA = G_OG + (size_t)TR * 8192 * 2;
constexpr size_t BLOBA_SZ = 32768;
constexpr size_t G_BLOBB = G_BLOBA + (size_t)132 * 32 * BLOBA_SZ;
constexpr size_t BLOBB_SZ = 25600;
constexpr size_t G_UF = G_QR;
constexpr size_t UF_SZ = 16384;
constexpr size_t G_END = G_BLOBB + (size_t)132 * 128 * BLOBB_SZ;
constexpr size_t P_U = WS_ACT;
constexpr size_t P_Z = P_U + (size_t)TR * 4096 * 4;
constexpr size_t P_M = P_Z + (size_t)TR * 4096 * 2;
constexpr size_t P_G = P_M + (size_t)TR * 4096 * 2;
constexpr size_t WS_YPART = G_END > A_MLA_END ? G_END : A_MLA_END;
constexpr int YPARTS = 16;
constexpr size_t WS_XB = WS_YPART + (size_t)YPARTS * 256 * 4096 * 4;
constexpr size_t WS_END = WS_XB + (size_t)8192 * 4096 * 2;

constexpr int LDS_STAGE = 131072;
constexpr int LDS_BYTES = LDS_STAGE + 256;
constexpr int ROWS_PRM = 1024;

typedef __bf16 bf16x2v __attribute__((ext_vector_type(2)));
__device__ __forceinline__ unsigned cvt_pk_bf16(float lo, float hi) { const f32x2 v = {lo, hi}; return __builtin_bit_cast(unsigned, __builtin_convertvector(v, bf16x2v)); }
__device__ __forceinline__ float bf_lo(unsigned w) { return __uint_as_float(w << 16); }
__device__ __forceinline__ float bf_hi(unsigned w) { return __uint_as_float(w & 0xffff0000u); }
__device__ __forceinline__ float bf2f(bf16_t b) { return __uint_as_float(((unsigned)b) << 16); }
__device__ __forceinline__ bf16_t f2bf(float f) { return (bf16_t)(cvt_pk_bf16(f, 0.f) & 0xffffu); }
__device__ __forceinline__ float silu_f(float z) { return z * __builtin_amdgcn_rcpf(1.f + __expf(-z)); }
__device__ __forceinline__ int lane_opaque() { int l; asm volatile("v_mbcnt_lo_u32_b32 %0, -1, 0\n\tv_mbcnt_hi_u32_b32 %0, -1, %0" : "=v"(l)); return l; }
__device__ __forceinline__ int tid_opaque(int wave) { return wave * 64 + lane_opaque(); }
__device__ __forceinline__ float wave_sum(float v) {
#pragma unroll
    for (int o = 32; o >= 1; o >>= 1) v += __shfl_xor(v, o);
    return v;
}

#define XB_TMO      128
#define XB_XCNT(j)  (256  + 64 * (j))
#define XB_XSUB(j)  (1280 + 64 * (j))
#define XB_XGEN(j)  (2304 + 64 * (j))
#define XB_TOP      3328
#define XB_TOPGEN   3392
#define XCD_BAR_WORDS 3456
#define XB_SPIN_CAP (1u << 22)

__device__ __forceinline__ unsigned xb_ld(unsigned* p)              { return __hip_atomic_load(p, __ATOMIC_RELAXED, __HIP_MEMORY_SCOPE_AGENT); }
__device__ __forceinline__ unsigned xb_add(unsigned* p, unsigned v) { return __hip_atomic_fetch_add(p, v, __ATOMIC_RELAXED, __HIP_MEMORY_SCOPE_AGENT); }
__device__ __forceinline__ unsigned xb_xcc_id() { return (unsigned)__builtin_amdgcn_s_getreg((3 << 11) | 20) & 0xFu; }
#define XB_SPIN(cond, bar) do { unsigned _sp = 0; while (cond) { __builtin_amdgcn_s_sleep(1); \
    if ((++_sp & 255u) == 0u) { if (xb_ld(&(bar)[XB_TMO])) break; if (_sp > XB_SPIN_CAP) { atomicAdd(&(bar)[XB_TMO], 1u); break; } } } } while (0)

struct XcdBarrier { unsigned* bar; unsigned x; volatile LAS unsigned* st; unsigned w; };
__device__ __forceinline__ bool xb_thread0(unsigned w) { return w == 0u && lane_opaque() == 0; }

__device__ __forceinline__ XcdBarrier xcd_barrier_post(unsigned* bar, volatile LAS unsigned* st, unsigned w) {
    XcdBarrier b; b.bar = bar; b.x = xb_xcc_id(); b.st = st; b.w = w;
    if (xb_thread0(w)) (void)xb_add(&bar[XB_XCNT(b.x)], 1u);
    return b;
}
__device__ __forceinline__ void xcd_barrier_complete(unsigned* bar, unsigned x, unsigned& nloc, unsigned& nx) {
    const unsigned G = gridDim.x * gridDim.y * gridDim.z;
    unsigned sum, cnt, mine, sp = 0u;
    for (;;) {
        sum = 0u; cnt = 0u; mine = 0u;
#pragma unroll
        for (unsigned j = 0; j < 16; ++j) { const unsigned c = xb_ld(&bar[XB_XCNT(j)]); sum += c; cnt += (c > 0u) ? 1u : 0u; mine = (j == x) ? c : mine; }
        if (sum == G) break;
        __builtin_amdgcn_s_sleep(1);
        if ((++sp & 255u) == 0u) { if (xb_ld(&bar[XB_TMO])) break; if (sp > XB_SPIN_CAP) { atomicAdd(&bar[XB_TMO], 1u); break; } }
    }
    nloc = mine > 0u ? mine : 1u; nx = cnt > 0u ? cnt : 1u;
}
__device__ __forceinline__ void xcd_barrier(const XcdBarrier& b) {
    asm volatile("s_waitcnt vmcnt(0)" ::: "memory");
    __syncthreads();
    if (xb_thread0(b.w)) {
        unsigned* bar = b.bar;
        __builtin_amdgcn_s_waitcnt(0);
        unsigned nloc = b.st[0], nx = b.st[1];
        if (nloc == 0u) { xcd_barrier_complete(bar, b.x, nloc, nx); b.st[0] = nloc; b.st[1] = nx; }
        const unsigned old = xb_add(&bar[XB_XSUB(b.x)], 1u);
        const unsigned gen = old / nloc;
        if (old + 1u == (gen + 1u) * nloc) {
            __builtin_amdgcn_fence(__ATOMIC_RELEASE, "agent");
            asm volatile("s_waitcnt vmcnt(0)" ::: "memory");
            const unsigned og = xb_add(&bar[XB_TOP], 1u);
            const unsigned tg = og / nx;
            if (og + 1u == (tg + 1u) * nx) xb_add(&bar[XB_TOPGEN], 1u);
            else XB_SPIN(xb_ld(&bar[XB_TOPGEN]) == tg, bar);
            __builtin_amdgcn_fence(__ATOMIC_ACQUIRE, "agent");
            xb_add(&bar[XB_XGEN(b.x)], 1u);
            asm volatile("s_waitcnt vmcnt(0)" ::: "memory");
        } else {
            XB_SPIN(xb_ld(&bar[XB_XGEN(b.x)]) == gen, bar);
            __builtin_amdgcn_fence(__ATOMIC_ACQUIRE, "agent");
            asm volatile("s_waitcnt vmcnt(0)" ::: "memory");
        }
    }
    __syncthreads();
}

namespace pg8 {
constexpr int BM = 256, BK = 64, HALF = 128, HTB = HALF * BK * 2, STAGE_BYTES = 8 * HTB, NXCD = 8, WGM = 8;
__host__ __device__ __forceinline__ int lds_byte(int r, int c) { const int st = (r >> 4) * 2 + (c >> 5), rr = r & 15, cc = c & 31, ob = rr * 64 + cc * 2; return st * 1024 + (ob ^ (((ob >> 9) & 1) << 5)); }
__host__ __device__ __forceinline__ void stage_rc(int b, int& R, int& C) { const int st = b / 1024, sb = b % 1024, swz = sb ^ (((sb >> 9) & 1) << 5); R = (st >> 1) * 16 + swz / 64; C = (st & 1) * 32 + (swz % 64) / 2; }
__host__ __device__ __forceinline__ int perm32(int rho) { const int n = rho >> 4, i = rho & 15; return 8 * (i >> 2) + 4 * n + (i & 3); }

struct Unit { int pm, pn; };
template <size_t A_OFF_, size_t B_OFF_, int N_, int K_, int LDA_, int LDB_, int GRP_, int MT0_ = 0, int MT_ = TR / 256 - MT0_, int SPLIT_ = 0, int ORD_ = 0>
struct GC { static constexpr size_t A_OFF = A_OFF_, B_OFF = B_OFF_; static constexpr int N = N_, K = K_, LDA = LDA_, LDB = LDB_, GRP = GRP_, MT0 = MT0_, MT = MT_, SPLIT = SPLIT_, ORD = ORD_; };

template <int nM, int nN>
__device__ __forceinline__ bool next_unit(int i, int G, int c, Unit& u) {
    constexpr int nwg = nM * nN;
    const int L = i * G + c; if (L >= nwg) return false;
    int wgid = L; { constexpr int q = nwg / NXCD, r = nwg % NXCD; const int xcd = wgid % NXCD, off = wgid / NXCD; wgid = (xcd < r ? xcd * (q + 1) : r * (q + 1) + (xcd - r) * q) + off; }
    constexpr int nig = WGM * nN; const int gid = wgid / nig, fm = gid * WGM, gsz = (nM - fm) < WGM ? (nM - fm) : WGM;
    u.pm = fm + ((wgid % nig) % gsz); u.pn = (wgid % nig) / gsz; return true;
}

template <int nM, int nN>
__device__ __forceinline__ bool next_unit_sweep(int i, int G, int c, Unit& u) {
    constexpr int nwg = nM * nN, PM = nM / NXCD, R = nM % NXCD, mainc = PM * nN;
    const int L = i * G + c; if (L >= nwg) return false;
    const int xcd = L % NXCD, off = L / NXCD;
    if (off < mainc) { u.pn = off / PM; u.pm = R + xcd * PM + off % PM; }
    else { const int t = xcd + NXCD * (off - mainc); u.pm = t / nN; u.pn = t % nN; }
    return true;
}
template <class G_, int nM, int nN>
__device__ __forceinline__ bool next_unit_sel(int i, int G, int c, Unit& u) {
    if (G_::ORD == 1) return next_unit_sweep<nM, nN>(i, G, c, u);
    return next_unit<nM, nN>(i, G, c, u);
}

template <class G_, class Epi>
__device__ __forceinline__ void gemm_phase(LAS unsigned char* lds, unsigned char* ws, int G, int c, const Epi& E, int wave) {
    const int tid = tid_opaque(wave), wid = wave, lane = tid & 63, wr = wid >> 2, wc = wid & 3, fr = lane & 15, fq = lane >> 4;
    constexpr int SP = G_::SPLIT > 0 ? G_::SPLIT : 1, K = G_::K / SP, nt = K / BK, nM = G_::MT, nN = (G_::N / BM) * SP;
    static_assert(K >= 256 && K % 128 == 0, "K per unit");
    unsigned voffA[2], voffB[2];
#pragma unroll
    for (int i = 0; i < 2; ++i) { int R, C; stage_rc(tid * 16 + i * 8192, R, C); const int Rb = (R & ~31) + perm32(R & 31);
        voffA[i] = (unsigned)(R * G_::LDA + C) * 2u; voffB[i] = (unsigned)(Rb * G_::LDB + C) * 2u; }
    constexpr unsigned kstep = BK * 2;
    constexpr unsigned hstepA = HALF * G_::LDA * 2, hstepB = HALF * G_::LDB * 2;
    constexpr unsigned tstepA = 2 * hstepA, tstepB = 2 * hstepB;
    const unsigned ldsw = (unsigned)wid * 1024u;
    const int aoff = lds_byte(wr * 64 + fr, fq * 8), boff = lds_byte(wc * 32 + fr, fq * 8);
    const char* const Abase = (const char*)(ws + G_::A_OFF); const char* const Bbase = (const char*)(ws + G_::B_OFF);
#define PG8_SA(b, h) (((b) * 2 + (h)) * HTB)
#define PG8_SB(b, h) ((4 + (b) * 2 + (h)) * HTB)
#define PG8_STAGE(bufoff, gbase, goff, voff) do { _Pragma("unroll") for (int _i = 0; _i < 2; ++_i) \
        __builtin_amdgcn_global_load_lds((const unsigned*)((gbase) + (size_t)((goff) + (voff)[_i])), (LAS unsigned*)(lds + (bufoff) + ldsw + _i * 8192), 16, 0, 0); } while (0)
#define PG8_LDA(dst, b, h) do { _Pragma("unroll") for (int m = 0; m < 4; ++m) _Pragma("unroll") for (int k = 0; k < 2; ++k) dst[m][k] = *(const LAS bf16x8*)(lds + PG8_SA(b, h) + aoff + m * 2048 + k * 1024); } while (0)
#define PG8_LDB(dst, b, h) do { _Pragma("unroll") for (int n = 0; n < 2; ++n) _Pragma("unroll") for (int k = 0; k < 2; ++k) dst[n][k] = *(const LAS bf16x8*)(lds + PG8_SB(b, h) + boff + n * 2048 + k * 1024); } while (0)
#define PG8_MMA(ai, bj, At, Bt) do { __builtin_amdgcn_s_setprio(1); _Pragma("unroll") for (int m = 0; m < 4; ++m) _Pragma("unroll") for (int n = 0; n < 2; ++n) _Pragma("unroll") for (int k = 0; k < 2; ++k) \
        acc[ai][bj][m][n] = __builtin_amdgcn_mfma_f32_16x16x32_bf16(Bt[n][k], At[m][k], acc[ai][bj][m][n], 0, 0, 0); __builtin_amdgcn_s_setprio(0); } while (0)
#define PG8_WAIT_V(n) asm volatile("s_waitcnt vmcnt(" #n ")" ::: "memory")
#define PG8_WAIT_L(n) asm volatile("s_waitcnt lgkmcnt(" #n ")" ::: "memory")
#define PG8_BAR __builtin_amdgcn_s_barrier()
#define PG8_SCHED __builtin_amdgcn_sched_barrier(0)
#define PG8_AOFF(u) ((unsigned)(u).pm * tstepA + (G_::GRP ? (unsigned)((u).pn / (G_::GRP ? G_::GRP : 1)) * (unsigned)(K * 2) : 0u) + (G_::SPLIT ? (unsigned)((u).pn % SP) * (unsigned)(K * 2) : 0u))
#define PG8_BOFF(u) ((unsigned)((u).pn / SP) * tstepB + (G_::SPLIT ? (unsigned)((u).pn % SP) * (unsigned)(K * 2) : 0u))
    Unit cur, nxt; int ui = 0;
    if (!next_unit_sel<G_, nM, nN>(0, G, c, cur)) return;
    cur.pm += G_::MT0;
    f32x4 acc[2][2][4][2];
#pragma unroll
    for (int a = 0; a < 2; ++a)
#pragma unroll
        for (int b = 0; b < 2; ++b)
#pragma unroll
            for (int m = 0; m < 4; ++m)
#pragma unroll
                for (int n = 0; n < 2; ++n) acc[a][b][m][n] = (f32x4){0.f, 0.f, 0.f, 0.f};
    bf16x8 At[4][2], B0[2][2], B1[2][2];
    unsigned cA = PG8_AOFF(cur), cB = PG8_BOFF(cur);
    PG8_STAGE(PG8_SB(0, 0), Bbase, cB, voffB); PG8_STAGE(PG8_SA(0, 0), Abase, cA, voffA); PG8_STAGE(PG8_SB(0, 1), Bbase, cB + hstepB, voffB); PG8_STAGE(PG8_SA(0, 1), Abase, cA + hstepA, voffA);
    if (wr == 1) PG8_BAR;
    PG8_WAIT_V(4); PG8_BAR;
    PG8_STAGE(PG8_SB(1, 0), Bbase, cB + kstep, voffB); PG8_STAGE(PG8_SA(1, 0), Abase, cA + kstep, voffA); PG8_STAGE(PG8_SB(1, 1), Bbase, cB + hstepB + kstep, voffB);
    PG8_WAIT_V(6); PG8_BAR;
    for (;;) {
        const bool has_next = next_unit_sel<G_, nM, nN>(ui + 1, G, c, nxt);
        nxt.pm += G_::MT0;
        const unsigned nA = has_next ? PG8_AOFF(nxt) : cA, nB = has_next ? PG8_BOFF(nxt) : cB;
        for (int t = 0; t < nt; t += 2) {
            const bool last = (t == nt - 2);
            const unsigned a1 = cA + (unsigned)(t + 1) * kstep;
            const unsigned a2 = last ? nA : cA + (unsigned)(t + 2) * kstep, b2 = last ? nB : cB + (unsigned)(t + 2) * kstep;
            const unsigned a3 = a2 + kstep, b3 = b2 + kstep;
            PG8_LDB(B0, 0, 0); PG8_SCHED; PG8_LDA(At, 0, 0); PG8_STAGE(PG8_SA(1, 1), Abase, a1 + hstepA, voffA);
            PG8_WAIT_L(8); PG8_BAR; PG8_WAIT_L(0); PG8_MMA(0, 0, At, B0); PG8_BAR; PG8_SCHED;
            PG8_LDB(B1, 0, 1); PG8_STAGE(PG8_SB(0, 0), Bbase, b2, voffB);
            PG8_BAR; PG8_WAIT_L(0); PG8_MMA(0, 1, At, B1); PG8_BAR;
            PG8_LDA(At, 0, 1); PG8_STAGE(PG8_SA(0, 0), Abase, a2, voffA);
            PG8_BAR; PG8_WAIT_L(0); PG8_MMA(1, 0, At, B0); PG8_BAR; PG8_SCHED;
            PG8_STAGE(PG8_SB(0, 1), Bbase, b2 + hstepB, voffB);
            PG8_WAIT_V(6); PG8_BAR; PG8_MMA(1, 1, At, B1); PG8_BAR;
            PG8_LDB(B0, 1, 0); PG8_SCHED; PG8_LDA(At, 1, 0); PG8_STAGE(PG8_SA(0, 1), Abase, a2 + hstepA, voffA);
            PG8_WAIT_L(8); PG8_BAR; PG8_WAIT_L(0); PG8_MMA(0, 0, At, B0); PG8_BAR; PG8_SCHED;
            PG8_LDB(B1, 1, 1); PG8_STAGE(PG8_SB(1, 0), Bbase, b3, voffB);
            PG8_BAR; PG8_WAIT_L(0); PG8_MMA(0, 1, At, B1); PG8_BAR;
            PG8_LDA(At, 1, 1); PG8_STAGE(PG8_SA(1, 0), Abase, a3, voffA);
            PG8_BAR; PG8_WAIT_L(0); PG8_MMA(1, 0, At, B0); PG8_BAR; PG8_SCHED;
            PG8_STAGE(PG8_SB(1, 1), Bbase, b3 + hstepB, voffB);
            PG8_WAIT_V(6); PG8_BAR; PG8_MMA(1, 1, At, B1); PG8_BAR;
        }
        E(acc, cur, wr, wc, fr, fq);
        if (!has_next) break;
#pragma unroll
        for (int a = 0; a < 2; ++a)
#pragma unroll
            for (int b = 0; b < 2; ++b)
#pragma unroll
                for (int m = 0; m < 4; ++m)
#pragma unroll
                    for (int n = 0; n < 2; ++n) acc[a][b][m][n] = (f32x4){0.f, 0.f, 0.f, 0.f};
        cur = nxt; cA = nA; cB = nB; ++ui;
    }
    PG8_WAIT_V(0);
    if (wr == 0) PG8_BAR;
    PG8_BAR;
#undef PG8_SA
#undef PG8_SB
#undef PG8_STAGE
#undef PG8_LDA
#undef PG8_LDB
#undef PG8_MMA
#undef PG8_WAIT_V
#undef PG8_WAIT_L
#undef PG8_BAR
#undef PG8_SCHED
#undef PG8_AOFF
#undef PG8_BOFF
}

template <size_t O0, int LD0, int F0, int PN1 = (1 << 20), size_t O1 = 0, int LD1 = 0, int F1 = 0, int PN2 = (1 << 20), size_t O2 = 0, int LD2 = 0, int F2 = 0, int PN3 = (1 << 20), size_t O3 = 0, int LD3 = 0, int F3 = 0>
struct SegCfg { static constexpr size_t o0 = O0, o1 = O1, o2 = O2, o3 = O3; static constexpr int ld0 = LD0, ld1 = LD1, ld2 = LD2, ld3 = LD3, f0 = F0, f1 = F1, f2 = F2, f3 = F3, pn1 = PN1, pn2 = PN2, pn3 = PN3; };
template <class SG, bool RS, bool NT = false>
struct EpiStore {
    unsigned char* ws; const float* rowscale;
    __device__ __forceinline__ void operator()(const f32x4 (&acc)[2][2][4][2], const Unit& u, int wr, int wc, int fr, int fq) const {
        size_t so; int ldc, pnb; bool isf;
        if (u.pn >= SG::pn3) { so = SG::o3; ldc = SG::ld3; pnb = SG::pn3; isf = SG::f3 != 0; }
        else if (u.pn >= SG::pn2) { so = SG::o2; ldc = SG::ld2; pnb = SG::pn2; isf = SG::f2 != 0; }
        else if (u.pn >= SG::pn1) { so = SG::o1; ldc = SG::ld1; pnb = SG::pn1; isf = SG::f1 != 0; }
        else { so = SG::o0; ldc = SG::ld0; pnb = 0; isf = SG::f0 != 0; }
        unsigned char* base = ws + so;
        const int row0 = u.pm * BM + wr * 64 + fr, col0 = (u.pn - pnb) * BM + wc * 32 + 8 * fq;
#pragma unroll
        for (int ai = 0; ai < 2; ++ai)
#pragma unroll
            for (int m = 0; m < 4; ++m) {
                const int row = row0 + ai * HALF + m * 16;
                const float rs = RS ? rowscale[row] : 1.f;
#pragma unroll
                for (int bj = 0; bj < 2; ++bj) {
                    f32x4 v0 = acc[ai][bj][m][0], v1 = acc[ai][bj][m][1];
                    if (RS) { v0 *= rs; v1 *= rs; }
                    const size_t off = (size_t)row * ldc + col0 + bj * HALF;
                    if (isf) { float* o = (float*)base + off; *(f32x4*)o = v0; *(f32x4*)(o + 4) = v1; }
                    else { u32x4 w; w.x = cvt_pk_bf16(v0[0], v0[1]); w.y = cvt_pk_bf16(v0[2], v0[3]); w.z = cvt_pk_bf16(v1[0], v1[1]); w.w = cvt_pk_bf16(v1[2], v1[3]);
                        if (NT) __builtin_nontemporal_store(w, (u32x4*)((bf16_t*)base + off)); else *(u32x4*)((bf16_t*)base + off) = w; }
                }
                if (RS && (m & 1)) asm volatile("" ::: "memory");
            }
    }
};
template <int SPLIT, int N>
struct EpiPart {
    float* part;
    __device__ __forceinline__ void operator()(const f32x4 (&acc)[2][2][4][2], const Unit& u, int wr, int wc, int fr, int fq) const {
        const int pt = u.pn % SPLIT, ct = u.pn / SPLIT;
        float* base = part + (size_t)pt * 256 * N + ct * BM + wc * 32 + 8 * fq;
#pragma unroll
        for (int ai = 0; ai < 2; ++ai)
#pragma unroll
            for (int m = 0; m < 4; ++m) {
                const int row = wr * 64 + fr + ai * HALF + m * 16;
#pragma unroll
                for (int bj = 0; bj < 2; ++bj) { float* o = base + (size_t)row * N + bj * HALF; *(f32x4*)o = acc[ai][bj][m][0]; *(f32x4*)(o + 4) = acc[ai][bj][m][1]; }
            }
    }
};
struct EpiPool {
    bf16_t* out; const bf16_t* z; const float* scale; int ld;
    __device__ __forceinline__ void operator()(const f32x4 (&acc)[2][2][4][2], const Unit& u, int wr, int wc, int fr, int fq) const {
        const int row0 = u.pm * BM + wr * 64 + fr, col0 = u.pn * BM + wc * 32 + 8 * fq;
        f32x4 sc[2][2];
#pragma unroll
        for (int bj = 0; bj < 2; ++bj) { sc[bj][0] = *(const f32x4*)(scale + col0 + bj * HALF); sc[bj][1] = *(const f32x4*)(scale + col0 + bj * HALF + 4); }
#pragma unroll
        for (int ai = 0; ai < 2; ++ai)
#pragma unroll
            for (int m = 0; m < 4; ++m) {
                const int row = row0 + ai * HALF + m * 16;
#pragma unroll
                for (int bj = 0; bj < 2; ++bj) {
                    const size_t off = (size_t)row * ld + col0 + bj * HALF;
                    const u32x4 zz = *(const u32x4*)(z + off);
                    f32x4 v0 = acc[ai][bj][m][0] * sc[bj][0], v1 = acc[ai][bj][m][1] * sc[bj][1];
                    v0[0] *= silu_f(bf_lo(zz.x)); v0[1] *= silu_f(bf_hi(zz.x)); v0[2] *= silu_f(bf_lo(zz.y)); v0[3] *= silu_f(bf_hi(zz.y));
                    v1[0] *= silu_f(bf_lo(zz.z)); v1[1] *= silu_f(bf_hi(zz.z)); v1[2] *= silu_f(bf_lo(zz.w)); v1[3] *= silu_f(bf_hi(zz.w));
                    u32x4 w; w.x = cvt_pk_bf16(v0[0], v0[1]); w.y = cvt_pk_bf16(v0[2], v0[3]); w.z = cvt_pk_bf16(v1[0], v1[1]); w.w = cvt_pk_bf16(v1[2], v1[3]);
                    *(u32x4*)(out + off) = w;
                }
            }
    }
};
}

namespace att {
constexpr int QBLK = 32, KVBLK = 64;
constexpr float SCALE = 0.07216878364870322f;
constexpr float THR = 8.f;
constexpr int LDQ = 6144, LDKV = 8192, LDR = 64, LDO = 4096;
constexpr int SHM_V = KVBLK * 128 * 2, SHM_K = KVBLK * 400;
#define KSWZ(row, colB) ((row) * 400 + (colB))
#define SBAR() __builtin_amdgcn_sched_barrier(0)
__device__ __forceinline__ int crow(int r, int hi) { return (r & 3) + 8 * (r >> 2) + 4 * hi; }

__device__ __forceinline__ void partialSM(f32x16& p0, f32x16& p1, float& m_reg, float& mn, float& alpha) {
    constexpr float C = SCALE * 1.4426950408889634f;
    float pmax = p0[0];
#pragma unroll
    for (int r = 1; r < 16; ++r) pmax = fmaxf(pmax, p0[r]);
#pragma unroll
    for (int r = 0; r < 16; ++r) pmax = fmaxf(pmax, p1[r]);
    { auto rr = __builtin_amdgcn_permlane32_swap(__float_as_uint(pmax), __float_as_uint(pmax), false, false);
      pmax = fmaxf(__uint_as_float(rr[0]), __uint_as_float(rr[1])); }
    if (__builtin_expect(__all(pmax - m_reg <= THR / SCALE), 1)) { mn = m_reg; alpha = 1.f; }
    else { mn = fmaxf(m_reg, pmax); alpha = __builtin_amdgcn_exp2f((m_reg - mn) * C); m_reg = mn; }
    float mnC = -mn * C;
#pragma unroll
    for (int r = 0; r < 16; ++r) p0[r] = fmaf(p0[r], C, mnC);
#pragma unroll
    for (int r = 0; r < 16; ++r) p1[r] = fmaf(p1[r], C, mnC);
#pragma unroll
    for (int r = 0; r < 16; ++r) p0[r] = __builtin_amdgcn_exp2f(p0[r]);
}
__device__ __forceinline__ void finishSM(f32x16& p0, f32x16& p1, float alpha, float& l_reg, bf16x8& pa0, bf16x8& pa1, bf16x8& pa2, bf16x8& pa3) {
#pragma unroll
    for (int r = 0; r < 16; ++r) p1[r] = __builtin_amdgcn_exp2f(p1[r]);
    float ps = 0;
#pragma unroll
    for (int r = 0; r < 16; ++r) ps += p0[r];
#pragma unroll
    for (int r = 0; r < 16; ++r) ps += p1[r];
    { auto rr = __builtin_amdgcn_permlane32_swap(__float_as_uint(ps), __float_as_uint(ps), false, false);
      ps = __uint_as_float(rr[0]) + __uint_as_float(rr[1]); }
    l_reg = l_reg * alpha + ps;
#define PK4(P, BASE, OUT) do { unsigned a0 = cvt_pk_bf16(P[BASE + 0], P[BASE + 1]), a1 = cvt_pk_bf16(P[BASE + 2], P[BASE + 3]);   \
    unsigned b0 = cvt_pk_bf16(P[BASE + 4], P[BASE + 5]), b1 = cvt_pk_bf16(P[BASE + 6], P[BASE + 7]);                              \
    auto r0 = __builtin_amdgcn_permlane32_swap(a0, b0, false, false); auto r1 = __builtin_amdgcn_permlane32_swap(a1, b1, false, false); \
    u32x4 w = {r0[0], r1[0], r0[1], r1[1]}; OUT = *reinterpret_cast<bf16x8*>(&w); } while (0)
    PK4(p0, 0, pa0); PK4(p0, 8, pa1); PK4(p1, 0, pa2); PK4(p1, 8, pa3);
#undef PK4
}
__device__ __forceinline__ void qkt(f32x16& p0, f32x16& p1, const char* Ks, const bf16x8* qr, int r32, int hi) {
    p0 = f32x16{}; p1 = f32x16{};
    __builtin_amdgcn_s_setprio(1);
#pragma unroll
    for (int d0 = 0; d0 < 12; ++d0) { int cb = (d0 * 16 + hi * 8) * 2;
        bf16x8 b0 = *reinterpret_cast<const bf16x8*>(Ks + KSWZ(r32, cb));
        bf16x8 b1 = *reinterpret_cast<const bf16x8*>(Ks + KSWZ(32 + r32, cb));
        p0 = __builtin_amdgcn_mfma_f32_32x32x16_bf16(b0, qr[d0], p0, 0, 0, 0);
        p1 = __builtin_amdgcn_mfma_f32_32x32x16_bf16(b1, qr[d0], p1, 0, 0, 0); }
    __builtin_amdgcn_s_setprio(0);
}
__device__ __forceinline__ int v_st(int k, int c) { const int kk = (k & ~0xC) | ((k & 4) << 1) | ((k & 8) >> 1); return ((kk >> 3) * 4 + (c >> 5)) * 512 + ((kk & 7) * 32 + (c & 31)) * 2; }
__device__ __forceinline__ int v_rd_base(int lane) { return ((lane & 3) << 3) | (((lane >> 2) & 3) << 6) | (((lane >> 4) & 1) << 5) | (((lane >> 5) & 1) << 8); }
constexpr int v_rd_off(int d0, int ks, int half) { return d0 * 512 + ks * 4096 + half * 2048; }
template <int OFF> __device__ __forceinline__ s16x4 tr_read(int vb) {
    s16x4 r; asm volatile("ds_read_b64_tr_b16 %0, %1 offset:%2" : "=&v"(r) : "v"(vb), "i"(OFF) : "memory"); return r;
}
template <int D0> __device__ __forceinline__ void pv_one(f32x16& od, int vb, bf16x8 pa0, bf16x8 pa1, bf16x8 pa2, bf16x8 pa3) {
    const s16x4 l0 = tr_read<v_rd_off(D0, 0, 0)>(vb), h0 = tr_read<v_rd_off(D0, 0, 1)>(vb), l1 = tr_read<v_rd_off(D0, 1, 0)>(vb), h1 = tr_read<v_rd_off(D0, 1, 1)>(vb);
    const s16x4 l2 = tr_read<v_rd_off(D0, 2, 0)>(vb), h2 = tr_read<v_rd_off(D0, 2, 1)>(vb), l3 = tr_read<v_rd_off(D0, 3, 0)>(vb), h3 = tr_read<v_rd_off(D0, 3, 1)>(vb);
    asm volatile("s_waitcnt lgkmcnt(0)" ::: "memory"); SBAR();
#define PK(L, H) (bf16x8){L[0], L[1], L[2], L[3], H[0], H[1], H[2], H[3]}
    od = __builtin_amdgcn_mfma_f32_32x32x16_bf16(pa0, PK(l0, h0), od, 0, 0, 0);
    od = __builtin_amdgcn_mfma_f32_32x32x16_bf16(pa1, PK(l1, h1), od, 0, 0, 0);
    od = __builtin_amdgcn_mfma_f32_32x32x16_bf16(pa2, PK(l2, h2), od, 0, 0, 0);
    od = __builtin_amdgcn_mfma_f32_32x32x16_bf16(pa3, PK(l3, h3), od, 0, 0, 0);
#undef PK
}
__device__ __forceinline__ void pv_d0(f32x16* o, int vb, bf16x8 pa0, bf16x8 pa1, bf16x8 pa2, bf16x8 pa3) {
    pv_one<0>(o[0], vb, pa0, pa1, pa2, pa3); pv_one<1>(o[1], vb, pa0, pa1, pa2, pa3); pv_one<2>(o[2], vb, pa0, pa1, pa2, pa3); pv_one<3>(o[3], vb, pa0, pa1, pa2, pa3);
}
__device__ __forceinline__ void pv_psm(f32x16* o, int vb, bf16x8 pa0, bf16x8 pa1, bf16x8 pa2, bf16x8 pa3, f32x16& p0, f32x16& p1, float& m_reg, float& mn, float& alpha) {
    constexpr float C = SCALE * 1.4426950408889634f;
    pv_one<0>(o[0], vb, pa0, pa1, pa2, pa3);
    float pmax = p0[0];
#pragma unroll
    for (int r = 1; r < 16; ++r) pmax = fmaxf(pmax, p0[r]);
    pv_one<1>(o[1], vb, pa0, pa1, pa2, pa3);
#pragma unroll
    for (int r = 0; r < 16; ++r) pmax = fmaxf(pmax, p1[r]);
    { auto rr = __builtin_amdgcn_permlane32_swap(__float_as_uint(pmax), __float_as_uint(pmax), false, false);
      pmax = fmaxf(__uint_as_float(rr[0]), __uint_as_float(rr[1])); }
    if (__builtin_expect(__all(pmax - m_reg <= THR / SCALE), 1)) { mn = m_reg; alpha = 1.f; }
    else { mn = fmaxf(m_reg, pmax); alpha = __builtin_amdgcn_exp2f((m_reg - mn) * C); m_reg = mn; }
    const float mnC = -mn * C;
    pv_one<2>(o[2], vb, pa0, pa1, pa2, pa3);
#pragma unroll
    for (int r = 0; r < 16; ++r) p0[r] = fmaf(p0[r], C, mnC);
#pragma unroll
    for (int r = 0; r < 16; ++r) p0[r] = __builtin_amdgcn_exp2f(p0[r]);
    pv_one<3>(o[3], vb, pa0, pa1, pa2, pa3);
#pragma unroll
    for (int r = 0; r < 16; ++r) p1[r] = fmaf(p1[r], C, mnC);
}

__device__ __forceinline__ void attn_body(const bf16_t* __restrict__ Qb, const bf16_t* __restrict__ Kn, const bf16_t* __restrict__ Kr, const bf16_t* __restrict__ Vh,
                                          const bf16_t* __restrict__ Zb, bf16_t* __restrict__ Ob, int seq, char* lds, int wave, const float* __restrict__ rope  ) {
    const int tid = tid_opaque(wave), wid = wave, lane = tid & 63, r32 = lane & 31, hi = lane >> 5;
    char* V_lds = lds; char* K_lds = lds + 2 * SHM_V;
    float* ws = (float*)(lds + 2 * SHM_V + 2 * SHM_K) + wid * 64; float* li_l = ws; float* al_l = ws + 32;
    float m_reg = -1e30f, l_reg = 0; f32x16 o[4] = {}; bf16x8 qr[12];
    const bf16_t* Qw = Qb + (long)(wid * QBLK + r32) * LDQ + hi * 8;
#pragma unroll
    for (int d0 = 0; d0 < 12; ++d0) qr[d0] = *reinterpret_cast<const bf16x8*>(Qw + d0 * 16);
    if (rope) {
        const float* tp = rope + (size_t)(wid * QBLK + r32) * 64 + hi * 8;
#pragma unroll
        for (int h = 0; h < 2; ++h) {
            const f32x4 c0 = *(const f32x4*)(tp + 16 * h), c1 = *(const f32x4*)(tp + 16 * h + 4), s0 = *(const f32x4*)(tp + 32 + 16 * h), s1 = *(const f32x4*)(tp + 32 + 16 * h + 4);
            const u32x4 a = *reinterpret_cast<const u32x4*>(&qr[8 + h]), b = *reinterpret_cast<const u32x4*>(&qr[10 + h]);
            u32x4 oa, ob;
#define ROT(W, CA, CB, SA, SB) do { const float x1l = bf_lo(a.W), x1h = bf_hi(a.W), x2l = bf_lo(b.W), x2h = bf_hi(b.W); \
            oa.W = cvt_pk_bf16(x1l * (CA) - x2l * (SA), x1h * (CB) - x2h * (SB)); ob.W = cvt_pk_bf16(x1l * (SA) + x2l * (CA), x1h * (SB) + x2h * (CB)); } while (0)
            ROT(x, c0[0], c0[1], s0[0], s0[1]); ROT(y, c0[2], c0[3], s0[2], s0[3]); ROT(z, c1[0], c1[1], s1[0], s1[1]); ROT(w, c1[2], c1[3], s1[2], s1[3]);
#undef ROT
            qr[8 + h] = *reinterpret_cast<const bf16x8*>(&oa); qr[10 + h] = *reinterpret_cast<const bf16x8*>(&ob);
        }
    }
    const int sr = tid >> 4, sc = (tid & 15) * 8, vst0 = v_st(sr, sc), vst1 = v_st(32 + sr, sc);
    const int rr_ = tid >> 3, rc_ = (tid & 7) * 8;
    const int vb0 = (int)(uintptr_t)V_lds + v_rd_base(lane);
    bf16x8 vs0, vs1, ks0, ks1, kr0;
    const unsigned oV0 = (unsigned)(sr * LDKV + sc), oV1 = (unsigned)((32 + sr) * LDKV + sc), oR = (unsigned)(rr_ * LDR + rc_);
#define SLOAD(k0) do { const bf16_t* vt_ = Vh + (size_t)(k0) * LDKV; const bf16_t* kt_ = Kn + (size_t)(k0) * LDKV; const bf16_t* rt_ = Kr + (size_t)(k0) * LDR; \
    vs0 = *reinterpret_cast<const bf16x8*>(vt_ + oV0); vs1 = *reinterpret_cast<const bf16x8*>(vt_ + oV1); \
    ks0 = *reinterpret_cast<const bf16x8*>(kt_ + oV0); ks1 = *reinterpret_cast<const bf16x8*>(kt_ + oV1); \
    kr0 = *reinterpret_cast<const bf16x8*>(rt_ + oR); } while (0)
#define SWRITE(b) do { *(bf16x8*)(V_lds + (b) * SHM_V + vst0) = vs0; *(bf16x8*)(V_lds + (b) * SHM_V + vst1) = vs1; int kc = sc * 2;  \
    *(bf16x8*)(K_lds + (b) * SHM_K + KSWZ(sr, kc)) = ks0; *(bf16x8*)(K_lds + (b) * SHM_K + KSWZ(32 + sr, kc)) = ks1;                      \
    *(bf16x8*)(K_lds + (b) * SHM_K + KSWZ(rr_, 256 + rc_ * 2)) = kr0; } while (0)
#define SWAIT() asm volatile("s_waitcnt vmcnt(0)" ::: "memory")
#define RESC(a) do { if (__any((a) < 1.f)) { if (hi == 0) al_l[r32] = (a); asm volatile("s_waitcnt lgkmcnt(0)" ::: "memory"); \
    _Pragma("unroll") for (int d = 0; d < 4; ++d) _Pragma("unroll") for (int r = 0; r < 16; ++r) o[d][r] *= al_l[crow(r, hi)]; } } while (0)
    f32x16 pA0, pA1, pB0, pB1; float mnA, mnB, alA, alB; bf16x8 pa0, pa1, pa2, pa3; const int NT = seq / KVBLK;
    SLOAD(0); SWAIT(); SWRITE(0); __syncthreads();
    qkt(pA0, pA1, K_lds, qr, r32, hi); partialSM(pA0, pA1, m_reg, mnA, alA);
    SLOAD(KVBLK);
    SWAIT(); SWRITE(1); __syncthreads();
    for (int j = 1; j + 1 < NT; j += 2) {
        SBAR(); qkt(pB0, pB1, K_lds + SHM_K, qr, r32, hi);
        finishSM(pA0, pA1, alA, l_reg, pa0, pa1, pa2, pa3); SBAR();
        SLOAD((j + 1) * KVBLK); SBAR();
        pv_psm(o, vb0, pa0, pa1, pa2, pa3, pB0, pB1, m_reg, mnB, alB);
        __syncthreads(); SWAIT(); SWRITE(0);
        RESC(alB); __syncthreads();
        SBAR(); qkt(pA0, pA1, K_lds, qr, r32, hi);
        finishSM(pB0, pB1, alB, l_reg, pa0, pa1, pa2, pa3); SBAR();
        SLOAD((j + 2) * KVBLK); SBAR();
        pv_psm(o, vb0 + SHM_V, pa0, pa1, pa2, pa3, pA0, pA1, m_reg, mnA, alA);
        __syncthreads(); SWAIT(); SWRITE(1);
        RESC(alA); __syncthreads();
    }
    SBAR(); qkt(pB0, pB1, K_lds + SHM_K, qr, r32, hi);
    finishSM(pA0, pA1, alA, l_reg, pa0, pa1, pa2, pa3); SBAR();
    pv_psm(o, vb0, pa0, pa1, pa2, pa3, pB0, pB1, m_reg, mnB, alB);
    __syncthreads(); RESC(alB);
    finishSM(pB0, pB1, alB, l_reg, pa0, pa1, pa2, pa3); SBAR();
    pv_d0(o, vb0 + SHM_V, pa0, pa1, pa2, pa3);
    if (hi == 0) li_l[r32] = l_reg; asm volatile("s_waitcnt lgkmcnt(0)" ::: "memory");
    float rli[16];
#pragma unroll
    for (int r = 0; r < 16; ++r) rli[r] = __builtin_amdgcn_rcpf(li_l[crow(r, hi)]);
    unsigned wrow = (unsigned)((wid * QBLK + 4 * hi) * LDO + r32);
    asm volatile("" : "+v"(wrow));
#pragma unroll
    for (int r = 0; r < 16; ++r) { const unsigned off = wrow + (unsigned)(((r & 3) + 8 * (r >> 2)) * LDO);
#pragma unroll
        for (int d0 = 0; d0 < 4; ++d0) { const float z = bf2f(Zb[off + d0 * 32]); Ob[off + d0 * 32] = f2bf(o[d0][r] * rli[r] * silu_f(z)); }
        if (r & 1) asm volatile("" ::: "memory"); }
#undef SLOAD
#undef SWRITE
#undef SWAIT
#undef RESC
}
}

struct TJob { const float* src; const float* scale; bf16_t* dst; int ld_src; int K; int ncols; int tile0; };
struct Params {
    const float* in[24]; float* out; unsigned char* ws;
    int ph_lo, ph_hi, njobs, ntiles, ntiles_early, pad_, ntiles_l3, pad2_;
    TJob jobs[24];
};
struct Ctx { int tid, lane, wave, bid, G; unsigned char* ws; LAS unsigned char* lds; };

__device__ __forceinline__ void ph_adaln(const Ctx& C, const Params& p, const int u0, const int u1, const int b0) {
    LAS float* sl = (LAS float*)C.lds;
    LAS float* red = (LAS float*)(C.lds + 32768);
    if (C.bid >= b0 && u0 + (C.bid - b0) < u1) {
        for (int k = C.tid; k < 4096; k += 512) { sl[k] = silu_f(p.in[1][k]); sl[4096 + k] = silu_f(p.in[3][k]); }
        __syncthreads();
    }
    if (C.bid >= b0)
    for (int u = u0 + (C.bid - b0); u < u1; u += C.G) {
        const int layer = u / 48, col0 = (u % 48) * 256;
        const float* w = p.in[4] + (size_t)layer * 4096 * 12288 + col0 + 4 * C.lane;
        f32x4 al = {0.f, 0.f, 0.f, 0.f}, ac = {0.f, 0.f, 0.f, 0.f};
        for (int k0 = C.wave; k0 < 4096; k0 += 128) {
            f32x4 wv[16];
#pragma unroll
            for (int i = 0; i < 16; ++i) wv[i] = *(const f32x4*)(w + (size_t)(k0 + 8 * i) * 12288);
#pragma unroll
            for (int i = 0; i < 16; ++i) { const float a = sl[k0 + 8 * i], b = sl[4096 + k0 + 8 * i]; al += wv[i] * a; ac += wv[i] * b; }
        }
#pragma unroll
        for (int j = 0; j < 4; ++j) { red[(C.wave * 256 + 4 * C.lane + j) * 2 + 0] = al[j]; red[(C.wave * 256 + 4 * C.lane + j) * 2 + 1] = ac[j]; }
        __syncthreads();
        { const int cond = C.tid >> 8, col = C.tid & 255; float s = 0.f;
#pragma unroll
          for (int wv = 0; wv < 8; ++wv) s += red[(wv * 256 + col) * 2 + cond];
          float* mod = (float*)(C.ws + WS_MOD);
          mod[((size_t)layer * 2 + cond) * 12288 + col0 + col] = s + p.in[5][(size_t)layer * 12288 + col0 + col]; }
        __syncthreads();
    }
}
struct WTile { f32x4 a0, a1, b0, b1; bf16_t* dst; int K, n0, k0; };
__device__ __forceinline__ void wconv_load(const Params& p, int tix, int tid, WTile& t) {
    int j = 0;
    while (j + 1 < p.njobs && tix >= p.jobs[j + 1].tile0) ++j;
    const TJob jb = p.jobs[j];
    const int local = tix - jb.tile0, nkt = jb.K / 128, nb = local / nkt, kb = local - nb * nkt;
    t.dst = jb.dst; t.K = jb.K; t.n0 = nb * 64; t.k0 = kb * 128;
    const int kp = (tid >> 3) * 2, nq = (tid & 7) * 8;
    t.a0 = (f32x4){0.f, 0.f, 0.f, 0.f}; t.a1 = t.a0; t.b0 = t.a0; t.b1 = t.a0;
    if (jb.src) {
        const float* s0 = jb.src + (size_t)(t.k0 + kp) * jb.ld_src + t.n0 + nq;
        t.a0 = *(const f32x4*)s0; t.a1 = *(const f32x4*)(s0 + 4); t.b0 = *(const f32x4*)(s0 + jb.ld_src); t.b1 = *(const f32x4*)(s0 + jb.ld_src + 4);
        if (jb.scale) { const float sa = jb.scale[t.k0 + kp], sb = jb.scale[t.k0 + kp + 1]; t.a0 *= sa; t.a1 *= sa; t.b0 *= sb; t.b1 *= sb; }
    }
}
constexpr int ADA_W = 64;
template <int MODE>
__device__ __forceinline__ void ph_wconv(const Ctx& C, const Params& p, const int t0, const int t1) {
    LAS unsigned* T = (LAS unsigned*)C.lds;
    const int nt_ = t1 - t0;
    int n1, n2, nb, b;
    int na = 0;
    if (MODE == 2) { if (C.bid < 129) return; nb = C.G - 129; b = C.bid - 129; n1 = (nt_ + nb - 1) / nb; n2 = 0; }
    else if (MODE == 3) { if (C.bid < 32) return; nb = C.G - 32; b = C.bid - 32; n1 = (nt_ + nb - 1) / nb; n2 = 0; }
    else if (MODE == 1) { if (C.G == 256) { if (C.bid < 128) return; nb = 128; b = C.bid - 128; na = 48; n1 = nt_ > 80 * ADA_W ? (nt_ - 80 * ADA_W) / 128 : 0; n2 = b >= 48 ? (nt_ - n1 * 128 + 79) / 80 : 0; }
        else { if (C.G > 128) { if (C.bid < 128) return; nb = C.G - 128; b = C.bid - 128; } else { nb = C.G; b = C.bid; }
            n1 = (nt_ + nb - 1) / nb; n2 = 0; } }
    else if (C.G == 256 && nt_ > 256 * 32) { nb = 256; b = C.bid; na = 144; n1 = (nt_ - 112 * ADA_W) / 256; n2 = C.bid >= 144 ? (nt_ - n1 * 256 + 111) / 112 : 0; }
    else { nb = C.G; b = C.bid; n1 = (nt_ + C.G - 1) / C.G; n2 = 0; }
#define WC_TIX(i) (t0 + ((i) < n1 ? (i) * nb + b : n1 * nb + ((i) - n1) * (nb - na) + (b - na)))
    WTile cur, nxt, nx2;
    if (n1 + n2 > 0 && WC_TIX(0) < t1) wconv_load(p, WC_TIX(0), C.tid, cur);
    if (n1 + n2 > 1 && WC_TIX(1) < t1) wconv_load(p, WC_TIX(1), C.tid, nxt);
    for (int i = 0; i < n1 + n2; ++i) {
        const int tix = WC_TIX(i);
        if (tix >= t1) break;
        if (i + 2 < n1 + n2 && WC_TIX(i + 2) < t1) wconv_load(p, WC_TIX(i + 2), C.tid, nx2);
        { const int kp = (C.tid >> 3) * 2, nq = (C.tid & 7) * 8;
#pragma unroll
          for (int q = 0; q < 4; ++q) { T[(nq + q) * 65 + (kp >> 1)] = cvt_pk_bf16(cur.a0[q], cur.b0[q]); T[(nq + 4 + q) * 65 + (kp >> 1)] = cvt_pk_bf16(cur.a1[q], cur.b1[q]); } }
        __syncthreads();
#pragma unroll
        for (int r_ = 0; r_ < 2; ++r_) { const int c = C.tid & 15, n = (C.tid >> 4) + 32 * r_;
            u32x4 v; v.x = T[n * 65 + c * 4]; v.y = T[n * 65 + c * 4 + 1]; v.z = T[n * 65 + c * 4 + 2]; v.w = T[n * 65 + c * 4 + 3];
            *(u32x4*)(cur.dst + (size_t)(cur.n0 + n) * cur.K + cur.k0 + c * 8) = v; }
        __syncthreads();
        cur = nxt; nxt = nx2;
    }
#undef WC_TIX
}
__device__ __forceinline__ void ph_rope_table(const Ctx& C) {
    float* tab = (float*)(C.ws + WS_ROPE);
    for (int idx = C.bid * 512 + C.tid; idx < 8192 * 32; idx += C.G * 512) {
        const int pos = idx >> 5, f = idx & 31, i = f & 15;
        const float inv = powf(10000.0f, -(float)i / 16.0f);
        const float ang = (float)((f < 16) ? (pos >> 6) : (pos & 63)) * inv;
        tab[pos * 64 + f] = cosf(ang); tab[pos * 64 + 32 + f] = sinf(ang);
    }
}

template <int MODE>
__device__ __forceinline__ void rows_ctx(const Ctx& C, const Params& p, int layer, int nlayer) {
    const float* mod = (const float*)(C.ws + WS_MOD);
    bf16_t* h = (bf16_t*)(C.ws + WS_H);
    float* xc = (float*)(C.ws + WS_XC);
    const float* ypart = (const float*)(C.ws + WS_YPART);
    LAS float* red = (LAS float*)C.lds;
    for (int row = C.bid; row < NCTX; row += C.G) {
        const int c = 8 * C.tid;
        const float* xsrc = (MODE == 0 || layer == 0) ? p.in[2] + (size_t)row * DM : xc + (size_t)row * DM;
        f32x4 x0 = *(const f32x4*)(xsrc + c), x1 = *(const f32x4*)(xsrc + c + 4);
        if (MODE >= 1) {
            const unsigned voff = (unsigned)c * 4u;
            f32x4 y0 = {0.f, 0.f, 0.f, 0.f}, y1 = y0;
#pragma unroll
            for (int hb = 0; hb < YPARTS; hb += 8) {
                f32x4 pa[8], pb[8];
#pragma unroll
                for (int pt = 0; pt < 8; ++pt) { const char* pp = (const char*)(ypart + ((size_t)(hb + pt) * 256 + row) * DM); pa[pt] = *(const f32x4*)(pp + voff); pb[pt] = *(const f32x4*)(pp + voff + 16); }
#pragma unroll
                for (int pt = 0; pt < 8; ++pt) { y0 += pa[pt]; y1 += pb[pt]; }
            }
            float ss = y0[0] * y0[0] + y0[1] * y0[1] + y0[2] * y0[2] + y0[3] * y0[3] + y1[0] * y1[0] + y1[1] * y1[1] + y1[2] * y1[2] + y1[3] * y1[3];
            ss = wave_sum(ss);
            if (C.lane == 0) red[C.wave] = ss;
            __syncthreads();
            float tot = 0.f;
#pragma unroll
            for (int w = 0; w < 8; ++w) tot += red[w];
            const float rs = rsqrtf(tot * (1.f / DM) + EPS);
            const float* gt = mod + ((size_t)layer * 2 + 1) * 12288 + 8192 + c;
            const float* np = p.in[7] + (size_t)layer * DM + c;
            x0 += *(const f32x4*)gt * (y0 * rs * *(const f32x4*)np); x1 += *(const f32x4*)(gt + 4) * (y1 * rs * *(const f32x4*)(np + 4));
            *(f32x4*)(xc + (size_t)row * DM + c) = x0; *(f32x4*)(xc + (size_t)row * DM + c + 4) = x1;
        }
        {
            float ss = x0[0] * x0[0] + x0[1] * x0[1] + x0[2] * x0[2] + x0[3] * x0[3] + x1[0] * x1[0] + x1[1] * x1[1] + x1[2] * x1[2] + x1[3] * x1[3];
            ss = wave_sum(ss);
            if (C.lane == 0) red[8 + C.wave] = ss;
            __syncthreads();
            float tot = 0.f;
#pragma unroll
            for (int w = 0; w < 8; ++w) tot += red[8 + w];
            const float rs = rsqrtf(tot * (1.f / DM) + EPS);
            const float* sh = mod + ((size_t)nlayer * 2 + 1) * 12288 + c; const float* sc = sh + 4096;
            const float* np = p.in[6] + (size_t)nlayer * DM + c;
            const f32x4 v0 = (x0 * rs * *(const f32x4*)np) * (*(const f32x4*)sc + 1.f) + *(const f32x4*)sh;
            const f32x4 v1 = (x1 * rs * *(const f32x4*)(np + 4)) * (*(const f32x4*)(sc + 4) + 1.f) + *(const f32x4*)(sh + 4);
            u32x4 w; w.x = cvt_pk_bf16(v0[0], v0[1]); w.y = cvt_pk_bf16(v0[2], v0[3]); w.z = cvt_pk_bf16(v1[0], v1[1]); w.w = cvt_pk_bf16(v1[2], v1[3]);
            *(u32x4*)(h + (size_t)row * DM + c) = w;
        }
        __syncthreads();
    }
}
template <int MODE, bool XF32>
__device__ __forceinline__ void rows_lat_one(const Ctx& C, const Params& p, const int layer, const int nlayer, const int row, f32x4 (&xv)[16], const u32x2 (&xw)[16], const u32x2 (&yw)[16]) {
    int ln = C.lane; asm volatile("" : "+v"(ln));
    const float* mod = (const float*)(C.ws + WS_MOD);
    if (!XF32) {
#pragma unroll
        for (int q = 0; q < 16; ++q) xv[q] = (f32x4){bf_lo(xw[q].x), bf_hi(xw[q].x), bf_lo(xw[q].y), bf_hi(xw[q].y)};
    }
    if (MODE >= 1) {
        float ss = 0.f;
#pragma unroll
        for (int q = 0; q < 16; ++q) { const float a = bf_lo(yw[q].x), b = bf_hi(yw[q].x), c_ = bf_lo(yw[q].y), d = bf_hi(yw[q].y); ss += a * a + b * b + c_ * c_ + d * d; }
        ss = wave_sum(ss);
        __builtin_amdgcn_sched_barrier(0);
        const float rs = rsqrtf(ss * (1.f / DM) + EPS);
        const LAS f32x4* gnl = (const LAS f32x4*)(C.lds + ROWS_PRM) + ln;
        float* xo = p.out + (size_t)(row - NCTX) * DM + 4 * ln; bf16_t* xb = (bf16_t*)(C.ws + WS_XB) + (size_t)(row - NCTX) * DM + 4 * ln;
#pragma unroll
        for (int q = 0; q < 16; ++q) { const f32x4 gn = gnl[64 * q];
            const f32x4 yv = {bf_lo(yw[q].x), bf_hi(yw[q].x), bf_lo(yw[q].y), bf_hi(yw[q].y)};
            xv[q] += gn * (yv * rs);
            if (MODE == 2) *(f32x4*)(xo + 256 * q) = xv[q];
            else { u32x2 w; w.x = cvt_pk_bf16(xv[q][0], xv[q][1]); w.y = cvt_pk_bf16(xv[q][2], xv[q][3]); *(u32x2*)(xb + 256 * q) = w; }
            if ((q & 1) == 1) asm volatile("" ::: "memory"); }
    }
    __builtin_amdgcn_sched_barrier(0);
    if (MODE != 2) {
        float ss = 0.f;
#pragma unroll
        for (int q = 0; q < 16; ++q) ss += xv[q][0] * xv[q][0] + xv[q][1] * xv[q][1] + xv[q][2] * xv[q][2] + xv[q][3] * xv[q][3];
        ss = wave_sum(ss);
        __builtin_amdgcn_sched_barrier(0);
        const float rs = rsqrtf(ss * (1.f / DM) + EPS);
        const LAS f32x4* al = (const LAS f32x4*)(C.lds + ROWS_PRM + 16384) + ln;
        bf16_t* ho = (bf16_t*)(C.ws + WS_H) + (size_t)row * DM + 4 * ln;
#pragma unroll
        for (int q = 0; q < 16; ++q) { const f32x4 a = al[64 * q], b = al[1024 + 64 * q];
            const f32x4 v = (xv[q] * rs) * a + b;
            u32x2 w; w.x = cvt_pk_bf16(v[0], v[1]); w.y = cvt_pk_bf16(v[2], v[3]);
            *(u32x2*)(ho + 256 * q) = w; if ((q & 1) == 1) asm volatile("" ::: "memory"); }
    }
    __builtin_amdgcn_sched_barrier(0);
}
template <int MODE, bool XF32, int NR>
__device__ __forceinline__ void rows_lat(const Ctx& C, const Params& p, const int layer, const int nlayer, const int row0, const int stride) {
    const bf16_t* y = (const bf16_t*)(C.ws + WS_Y);
    f32x4 xv[NR][16]; u32x2 xw[NR][16], yw[NR][16];
#pragma unroll
    for (int i = 0; i < NR; ++i) {
        int ln = C.lane; asm volatile("" : "+v"(ln));
        const int row = row0 + i * stride;
        if (XF32) { const float* xsrc = p.in[0] + (size_t)(row - NCTX) * DM + 4 * ln;
#pragma unroll
            for (int q = 0; q < 16; ++q) xv[i][q] = *(const f32x4*)(xsrc + 256 * q);
        } else { const bf16_t* xbr = (const bf16_t*)(C.ws + WS_XB) + (size_t)(row - NCTX) * DM + 4 * ln;
#pragma unroll
            for (int q = 0; q < 16; ++q) xw[i][q] = *(const u32x2*)(xbr + 256 * q);
        }
        if (MODE >= 1) { const bf16_t* yr = y + (size_t)row * DM + 4 * ln;
#pragma unroll
            for (int q = 0; q < 16; ++q) yw[i][q] = *(const u32x2*)(yr + 256 * q);
        }
    }
    __builtin_amdgcn_sched_barrier(0);
#pragma unroll
    for (int i = 0; i < NR; ++i) rows_lat_one<MODE, XF32>(C, p, layer, nlayer, row0 + i * stride, xv[i], xw[i], yw[i]);
}
template <int MODE>
__device__ __forceinline__ void ph_rows(const Ctx& C, const Params& p, int layer  , int nlayer  ) {
    {
        const float* mod = (const float*)(C.ws + WS_MOD);
        LAS f32x4* prm = (LAS f32x4*)(C.lds + ROWS_PRM);
        for (int i = C.tid; i < 1024; i += 512) {
            if (MODE >= 1) prm[i] = *(const f32x4*)(mod + ((size_t)layer * 2) * 12288 + 8192 + 4 * i) * *(const f32x4*)(p.in[7] + (size_t)layer * DM + 4 * i);
            if (MODE != 2) { const float* sh = mod + ((size_t)nlayer * 2) * 12288 + 4 * i;
                prm[1024 + i] = *(const f32x4*)(p.in[6] + (size_t)nlayer * DM + 4 * i) * (*(const f32x4*)(sh + 4096) + 1.f); prm[2048 + i] = *(const f32x4*)sh; }
        }
        __syncthreads();
    }
    if (MODE != 2) rows_ctx<MODE>(C, p, layer, nlayer);
    const int stride = C.G * 8;
    int row = NCTX + C.bid * 8 + C.wave;
    if (MODE == 0) {
        for (; row + stride < TR; row += 2 * stride) rows_lat<MODE, true, 2>(C, p, layer, nlayer, row, stride);
        if (row < TR) rows_lat<MODE, true, 1>(C, p, layer, nlayer, row, stride);
    } else if (layer == 0) {
        for (; row + stride < TR; row += 2 * stride) rows_lat<MODE, true, 2>(C, p, layer, nlayer, row, stride);
        if (row < TR) rows_lat<MODE, true, 1>(C, p, layer, nlayer, row, stride);
    } else {
        for (; row + stride < TR; row += 2 * stride) rows_lat<MODE, false, 2>(C, p, layer, nlayer, row, stride);
        if (row < TR) rows_lat<MODE, false, 1>(C, p, layer, nlayer, row, stride);
    }
}

template <int NR>
__device__ __forceinline__ void mla_stats_rows(const Ctx& C, const int row0, const int stride) {
    const bf16_t* cq = (const bf16_t*)(C.ws + A_CQ); const bf16_t* ckv = (const bf16_t*)(C.ws + A_CKV);
    const float* krraw = (const float*)(C.ws + A_KRRAW); bf16_t* kr = (bf16_t*)(C.ws + A_KR);
    float* rsq = (float*)(C.ws + A_RSQ); float* rskv = (float*)(C.ws + A_RSKV);
    const float* tab = (const float*)(C.ws + WS_ROPE);
    u32x4 va[NR], vb[NR], vk[NR]; float x1[NR], x2[NR], cs[NR], sn[NR];
#pragma unroll
    for (int i = 0; i < NR; ++i) { const int row = row0 + i * stride;
        va[i] = *(const u32x4*)(cq + (size_t)row * 1024 + 8 * C.lane); vb[i] = *(const u32x4*)(cq + (size_t)row * 1024 + 8 * (C.lane + 64));
        vk[i] = *(const u32x4*)(ckv + (size_t)row * 512 + 8 * C.lane);
        x1[i] = 0.f; x2[i] = 0.f; cs[i] = 1.f; sn[i] = 0.f;
        if (C.lane < 32) { x1[i] = krraw[(size_t)row * 256 + C.lane]; x2[i] = krraw[(size_t)row * 256 + 32 + C.lane];
            if (row >= NCTX) { cs[i] = tab[(size_t)(row - NCTX) * 64 + C.lane]; sn[i] = tab[(size_t)(row - NCTX) * 64 + 32 + C.lane]; } } }
#pragma unroll
    for (int i = 0; i < NR; ++i) { const int row = row0 + i * stride;
        float s1 = 0.f, s2 = 0.f;
        { const u32x4 v = va[i]; s1 += bf_lo(v.x) * bf_lo(v.x) + bf_hi(v.x) * bf_hi(v.x) + bf_lo(v.y) * bf_lo(v.y) + bf_hi(v.y) * bf_hi(v.y) + bf_lo(v.z) * bf_lo(v.z) + bf_hi(v.z) * bf_hi(v.z) + bf_lo(v.w) * bf_lo(v.w) + bf_hi(v.w) * bf_hi(v.w); }
        { const u32x4 v = vb[i]; s1 += bf_lo(v.x) * bf_lo(v.x) + bf_hi(v.x) * bf_hi(v.x) + bf_lo(v.y) * bf_lo(v.y) + bf_hi(v.y) * bf_hi(v.y) + bf_lo(v.z) * bf_lo(v.z) + bf_hi(v.z) * bf_hi(v.z) + bf_lo(v.w) * bf_lo(v.w) + bf_hi(v.w) * bf_hi(v.w); }
        { const u32x4 v = vk[i]; s2 += bf_lo(v.x) * bf_lo(v.x) + bf_hi(v.x) * bf_hi(v.x) + bf_lo(v.y) * bf_lo(v.y) + bf_hi(v.y) * bf_hi(v.y) + bf_lo(v.z) * bf_lo(v.z) + bf_hi(v.z) * bf_hi(v.z) + bf_lo(v.w) * bf_lo(v.w) + bf_hi(v.w) * bf_hi(v.w); }
        s1 = wave_sum(s1); s2 = wave_sum(s2);
        if (C.lane == 0) { rsq[row] = rsqrtf(s1 * (1.f / 1024.f) + EPS); rskv[row] = rsqrtf(s2 * (1.f / 512.f) + EPS); }
        if (C.lane < 32) { kr[(size_t)row * 64 + C.lane] = f2bf(x1[i] * cs[i] - x2[i] * sn[i]); kr[(size_t)row * 64 + 32 + C.lane] = f2bf(x1[i] * sn[i] + x2[i] * cs[i]); }
    }
}
__device__ __forceinline__ void ph_mla_stats(const Ctx& C) {
    const int stride = C.G * 8, nfull = TR / stride, row = C.bid * 8 + C.wave;
    int k = 0;
    for (; k + 4 <= nfull; k += 4) mla_stats_rows<4>(C, row + k * stride, stride);
    for (; k < nfull; ++k) mla_stats_rows<1>(C, row + k * stride, stride);
    for (int j = C.bid; j < TR - nfull * stride; j += C.G)
        if (C.wave == ((j / C.G + C.bid) & 7)) mla_stats_rows<1>(C, nfull * stride + j, stride);
}
__device__ __forceinline__ void ph_mla_ropeq(const Ctx& C) {
    bf16_t* q = (bf16_t*)(C.ws + A_Q);
    const float* tab = (const float*)(C.ws + WS_ROPE);
    for (int row = NCTX + C.bid * 8 + C.wave; row < TR; row += C.G * 8) {
        const int j = C.lane & 31;
        const float cs = tab[(size_t)(row - NCTX) * 64 + j], sn = tab[(size_t)(row - NCTX) * 64 + 32 + j];
#pragma unroll
        for (int it = 0; it < 16; ++it) { const int hh = (C.lane >> 5) + 2 * it;
            bf16_t* pq = q + (size_t)row * 6144 + hh * 192 + 128 + j;
            const float x1 = bf2f(pq[0]), x2 = bf2f(pq[32]);
            pq[0] = f2bf(x1 * cs - x2 * sn); pq[32] = f2bf(x1 * sn + x2 * cs); }
    }
}
template <int IT> __device__ __forceinline__ void ph_mla_attn(const Ctx& C, char* lds_generic) {
    const bf16_t* Q = (const bf16_t*)(C.ws + A_Q); const bf16_t* KV = (const bf16_t*)(C.ws + A_KV); const bf16_t* KR = (const bf16_t*)(C.ws + A_KR);
    const bf16_t* Z = (const bf16_t*)(C.ws + A_Z); bf16_t* OG = (bf16_t*)(C.ws + A_OG);
    for (int u = C.bid; u < 1024 + (IT ? 0 : 32); u += C.G) {
        int head, row0, seq;
        if (u < 1024) { const int r = u >> 8, b = u & 255; head = r * 8 + (b & 7); row0 = NCTX + (b >> 3) * 256; seq = TR; }
        else { head = u - 1024; row0 = 0; seq = NCTX; }
        size_t zo_ = 0; asm volatile("" : "+s"(zo_)); const bf16_t* KRu = KR + zo_;
        att::attn_body(Q + (size_t)row0 * 6144 + head * 192, KV + head * 256, KRu, KV + head * 256 + 128,
                       Z + (size_t)row0 * 4096 + head * 128, OG + (size_t)row0 * 4096 + head * 128, seq, lds_generic, C.wave,
                       u < 1024 ? (const float*)(C.ws + WS_ROPE) + (size_t)(row0 - NCTX) * 64 : nullptr);
    }
}

__device__ __forceinline__ int cperm16(int x) { return 8 * ((x >> 2) & 1) + (x & 3) + 4 * (x >> 3); }
__device__ __forceinline__ void ph_gdn_conv(const Ctx& C, const Params& p) {
    const bf16_t* P = (const bf16_t*)(C.ws + G_QKV);
    bf16_t* qr = (bf16_t*)(C.ws + G_QR); bf16_t* kr = (bf16_t*)(C.ws + G_KR); bf16_t* kt = (bf16_t*)(C.ws + G_KT); bf16_t* vt = (bf16_t*)(C.ws + G_VT);
    const float* cw = p.in[15];
    constexpr int TB = 16;
    for (int w = C.bid * 8 + C.wave; w < (TR / TB) * 128; w += C.G * 8) {
        const int grp = w & 127, t0 = (w >> 7) * TB;
        const int lo = t0 < NCTX ? 0 : NCTX, hi = t0 < NCTX ? NCTX : TR;
        const int c = grp * 128 + 2 * C.lane;
        f32x2 wj[5];
#pragma unroll
        for (int j = 0; j < 5; ++j) wj[j] = *(const f32x2*)(cw + (size_t)j * 16384 + c);
        unsigned raw[TB + 4];
#pragma unroll
        for (int i = 0; i < TB + 4; ++i) { const int r = t0 - 2 + i; raw[i] = (r >= lo && r < hi) ? *(const unsigned*)(P + (size_t)r * 16384 + c) : 0u; }
        float y0[TB], y1[TB], ss[TB];
#pragma unroll
        for (int t = 0; t < TB; ++t) {
            float a0 = 0.f, a1 = 0.f;
#pragma unroll
            for (int j = 0; j < 5; ++j) { a0 += bf_lo(raw[t + j]) * wj[j][0]; a1 += bf_hi(raw[t + j]) * wj[j][1]; }
            y0[t] = silu_f(a0); y1[t] = silu_f(a1); ss[t] = y0[t] * y0[t] + y1[t] * y1[t];
        }
        const int chunk = t0 >> 6, i0 = t0 & 63;
        const int dl = 2 * C.lane, dpos = (dl & ~15) + cperm16(dl & 15);
        if (grp < 64) {
#pragma unroll
            for (int o = 32; o >= 1; o >>= 1)
#pragma unroll
                for (int t = 0; t < TB; ++t) ss[t] += __shfl_xor(ss[t], o);
            const float qs = grp < 32 ? 0.08838834764831845f : 1.f;
#pragma unroll
            for (int t = 0; t < TB; ++t) { const float inv = rsqrtf(ss[t] + EPS) * qs; y0[t] *= inv; y1[t] *= inv; }
            bf16_t* dst = (grp < 32 ? qr + (size_t)(chunk * 32 + grp) * 8192 : kr + (size_t)(chunk * 32 + grp - 32) * 8192) + (size_t)i0 * 128 + dpos;
#pragma unroll
            for (int t = 0; t < TB; ++t) *(unsigned*)(dst + t * 128) = cvt_pk_bf16(y0[t], y1[t]);
        }
        if (grp >= 32) {
            bf16_t* tdst = (grp < 64 ? kt + (size_t)(chunk * 32 + grp - 32) * 8192 : vt + (size_t)(chunk * 64 + grp - 64) * 8192) + (size_t)dl * 64 + i0;
            u32x4 a, b;
            a.x = cvt_pk_bf16(y0[0], y0[1]); a.y = cvt_pk_bf16(y0[2], y0[3]); a.z = cvt_pk_bf16(y0[8], y0[9]); a.w = cvt_pk_bf16(y0[10], y0[11]);
            b.x = cvt_pk_bf16(y0[4], y0[5]); b.y = cvt_pk_bf16(y0[6], y0[7]); b.z = cvt_pk_bf16(y0[12], y0[13]); b.w = cvt_pk_bf16(y0[14], y0[15]);
            *(u32x4*)tdst = a; *(u32x4*)(tdst + 8) = b;
            a.x = cvt_pk_bf16(y1[0], y1[1]); a.y = cvt_pk_bf16(y1[2], y1[3]); a.z = cvt_pk_bf16(y1[8], y1[9]); a.w = cvt_pk_bf16(y1[10], y1[11]);
            b.x = cvt_pk_bf16(y1[4], y1[5]); b.y = cvt_pk_bf16(y1[6], y1[7]); b.z = cvt_pk_bf16(y1[12], y1[13]); b.w = cvt_pk_bf16(y1[14], y1[15]);
            *(u32x4*)(tdst + 64) = a; *(u32x4*)(tdst + 72) = b;
        }
    }
    const float* ab = (const float*)(C.ws + G_AB); float* gate = (float*)(C.ws + G_GATE);
    for (int idx = C.bid * 512 + C.tid; idx < TR * 128; idx += C.G * 512) {
        const int t = idx >> 7, dh = idx & 127, d = dh >> 6, hh = dh & 63;
        const float a = ab[(size_t)t * 256 + dh] + p.in[17][dh], b = ab[(size_t)t * 256 + 128 + dh];
        const float sp = fmaxf(a, 0.f) + log1pf(expf(-fabsf(a)));
        const float g = -expf(p.in[16][dh]) * sp;
        *(f32x2*)(gate + (((size_t)d * TR + t) * 64 + hh) * 2) = (f32x2){g, 1.f / (1.f + expf(-b))};
    }
}

__device__ __forceinline__ int perm16(int x) { return 8 * ((x >> 2) & 1) + (x & 3) + 4 * (x >> 3); }
__device__ __forceinline__ int permP(int X) { return (X & ~15) + perm16(X & 15); }
__device__ __forceinline__ int unperm(int hi, int s) { return 4 * hi + (s & 3) + 8 * (s >> 2); }
__device__ __forceinline__ bf16x8 pack8(float a0, float a1, float a2, float a3, float a4, float a5, float a6, float a7) {
    u32x4 w = {cvt_pk_bf16(a0, a1), cvt_pk_bf16(a2, a3), cvt_pk_bf16(a4, a5), cvt_pk_bf16(a6, a7)}; return *reinterpret_cast<bf16x8*>(&w);
}
#define MFMA32(a, b, c) __builtin_amdgcn_mfma_f32_32x32x16_bf16(a, b, c, 0, 0, 0)

__device__ __forceinline__ void ph_gdn_pre(const Ctx& C, const Params& p) {
    LAS unsigned char* L = C.lds;
    constexpr int O_KR = 0, O_QR = 17408, O_AM = 0, O_KK = 34816, O_QK = 51456, O_KT = 68096, O_VT = 86528, O_GC = 123392;
    LAS float* gc = (LAS float*)(L + O_GC);
    for (int item = C.bid; item < 132 * 32; item += C.G) {
        const int tid_ = tid_opaque(C.wave);
        const int lane = tid_ & 63, r32 = lane & 31, hi = lane >> 5, wv = __builtin_amdgcn_readfirstlane(tid_ >> 6);
        const int c = item >> 5, kh = item & 31, row0 = c * 64;
        size_t zo_ = 0; asm volatile("" : "+s"(zo_)); unsigned char* wsb = C.ws + zo_;
        unsigned char* blobA = wsb + G_BLOBA + (size_t)(c * 32 + kh) * BLOBA_SZ;
        {
            const bf16_t* P = (const bf16_t*)(wsb + G_QKV); const float* cw = p.in[15];
#pragma unroll 1
            for (int rep = 0; rep < 2; ++rep) {
                const int T_ = wv + 8 * rep, hsel = T_ & 3, tbk = T_ >> 2;
                const int ch0 = hsel == 0 ? kh * 128 : (hsel == 1 ? 4096 + kh * 128 : 8192 + (2 * kh + hsel - 2) * 128);
                const int cch = ch0 + 2 * lane, t0 = row0 + 16 * tbk;
                const int lo = t0 < NCTX ? 0 : NCTX, hi_ = t0 < NCTX ? NCTX : TR;
                f32x2 wj[5];
#pragma unroll
                for (int j = 0; j < 5; ++j) wj[j] = *(const f32x2*)(cw + (size_t)j * 16384 + cch);
                unsigned raw[20];
#pragma unroll
                for (int i = 0; i < 20; ++i) { const int r = t0 - 2 + i; raw[i] = (r >= lo && r < hi_) ? *(const unsigned*)(P + (size_t)r * 16384 + cch) : 0u; }
                float y0[16], y1[16], ss[16];
#pragma unroll
                for (int t = 0; t < 16; ++t) {
                    float a0 = 0.f, a1 = 0.f;
#pragma unroll
                    for (int j = 0; j < 5; ++j) { a0 += bf_lo(raw[t + j]) * wj[j][0]; a1 += bf_hi(raw[t + j]) * wj[j][1]; }
                    y0[t] = silu_f(a0); y1[t] = silu_f(a1); ss[t] = y0[t] * y0[t] + y1[t] * y1[t];
                }
                const int dl = 2 * lane, dpos = (dl & ~15) + cperm16(dl & 15);
                if (hsel < 2) {
#pragma unroll
                    for (int o = 1; o < 64; o <<= 1)
#pragma unroll
                        for (int t = 0; t < 16; ++t) ss[t] += __int_as_float(__builtin_amdgcn_ds_bpermute(((lane ^ o) & 63) << 2, __float_as_int(ss[t])));
                    const float qs = hsel == 0 ? 0.08838834764831845f : 1.f;
#pragma unroll
                    for (int t = 0; t < 16; ++t) { const float inv = rsqrtf(ss[t] + EPS) * qs; y0[t] *= inv; y1[t] *= inv; }
                    LAS unsigned char* dst = L + (hsel == 0 ? O_QR : O_KR) + (16 * tbk) * 272 + dpos * 2;
#pragma unroll
                    for (int t = 0; t < 16; ++t) *(LAS unsigned*)(dst + t * 272) = cvt_pk_bf16(y0[t], y1[t]);
                }
                if (hsel >= 1) {
                    LAS unsigned char* tdst = L + (hsel == 1 ? O_KT : O_VT + (hsel - 2) * 18432) + dl * 144 + 32 * tbk;
                    u32x4 a, b;
                    a.x = cvt_pk_bf16(y0[0], y0[1]); a.y = cvt_pk_bf16(y0[2], y0[3]); a.z = cvt_pk_bf16(y0[8], y0[9]); a.w = cvt_pk_bf16(y0[10], y0[11]);
                    b.x = cvt_pk_bf16(y0[4], y0[5]); b.y = cvt_pk_bf16(y0[6], y0[7]); b.z = cvt_pk_bf16(y0[12], y0[13]); b.w = cvt_pk_bf16(y0[14], y0[15]);
                    *(LAS u32x4*)tdst = a; *(LAS u32x4*)(tdst + 16) = b;
                    a.x = cvt_pk_bf16(y1[0], y1[1]); a.y = cvt_pk_bf16(y1[2], y1[3]); a.z = cvt_pk_bf16(y1[8], y1[9]); a.w = cvt_pk_bf16(y1[10], y1[11]);
                    b.x = cvt_pk_bf16(y1[4], y1[5]); b.y = cvt_pk_bf16(y1[6], y1[7]); b.z = cvt_pk_bf16(y1[12], y1[13]); b.w = cvt_pk_bf16(y1[14], y1[15]);
                    *(LAS u32x4*)(tdst + 144) = a; *(LAS u32x4*)(tdst + 144 + 16) = b;
                }
            }
        }
        __syncthreads();
        {
            const int mat = wv >> 2, ib = (wv >> 1) & 1, jb = wv & 1;
            f32x16 acc = {};
            bf16x8 af[8];
#pragma unroll
            for (int kb = 0; kb < 8; ++kb) {
                af[kb] = *(const LAS bf16x8*)(L + (mat ? O_QR : O_KR) + (32 * ib + r32) * 272 + (16 * kb + 8 * hi) * 2);
                const bf16x8 bfr = *(const LAS bf16x8*)(L + O_KR + (32 * jb + r32) * 272 + (16 * kb + 8 * hi) * 2);
                acc = MFMA32(af[kb], bfr, acc);
            }
            LAS float* dst = (LAS float*)(L + (mat ? O_QK : O_KK));
#pragma unroll
            for (int r = 0; r < 16; ++r) dst[(32 * ib + att::crow(r, hi)) * 65 + 32 * jb + r32] = acc[r];
            if (mat == 1 && jb == 0) {
#pragma unroll
                for (int kb = 0; kb < 8; ++kb) *(bf16x8*)(blobA + ((ib * 8 + kb) * 64 + lane) * 16) = af[kb];
            }
        }
        if (wv < 4) {
            const int dir = wv & 1, vh = 2 * kh + (wv >> 1);
            const float* ab = (const float*)(wsb + G_AB) + (size_t)(row0 + lane) * 256 + dir * 64 + vh;
            const float av_ = ab[0] + p.in[17][dir * 64 + vh], bv_ = ab[128];
            const float sp_ = fmaxf(av_, 0.f) + log1pf(expf(-fabsf(av_)));
            f32x2 gb; gb[0] = -expf(p.in[16][dir * 64 + vh]) * sp_; gb[1] = 1.f / (1.f + expf(-bv_));
            float g = gb[0];
            if (dir == 0) {
#pragma unroll
                for (int o = 1; o < 64; o <<= 1) { const float t = __int_as_float(__builtin_amdgcn_ds_bpermute(((lane - o) & 63) << 2, __float_as_int(g))); if (lane >= o) g += t; }
            } else {
#pragma unroll
                for (int o = 1; o < 64; o <<= 1) { const float t = __int_as_float(__builtin_amdgcn_ds_bpermute(((lane + o) & 63) << 2, __float_as_int(g))); if (lane + o < 64) g += t; }
            }
            gc[wv * 64 + lane] = g; gc[256 + wv * 64 + lane] = gb[1]; gc[512 + wv * 64 + lane] = -gb[1] * __expf(g);
            if (lane == (dir ? 0 : 63)) gc[768 + wv] = g;
        }
        __syncthreads();
        {
            const LAS float* KK = (const LAS float*)(L + O_KK); const LAS float* QK = (const LAS float*)(L + O_QK);
            float aval[32];
#pragma unroll
            for (int k = 0; k < 32; ++k) {
                const int n = tid_ + 512 * k, vi = n >> 12, dir = vi & 1, m = (n >> 6) & 63, i = n & 63;
                const bool valid = dir ? (i < m) : (i > m);
                const float e = __expf(gc[vi * 64 + i] - gc[vi * 64 + m]);
                aval[k] = valid ? gc[256 + vi * 64 + i] * KK[i * 65 + m] * e : 0.f;
            }
#pragma unroll
            for (int k = 0; k < 4; ++k) {
                const int n = tid_ + 512 * k, vi = n >> 9, dir = vi & 1, f = (n >> 6) & 7, ib = f >> 2, tb = f & 3, ln = n & 63, rr = ln & 31, hh = ln >> 5;
                const int i = 32 * ib + rr; const float gi = gc[vi * 64 + i];
                float qv[8];
#pragma unroll
                for (int sI = 0; sI < 8; ++sI) { const int j = 16 * tb + unperm(hh, sI); const bool valid = dir ? (j >= i) : (j <= i);
                    const float e = __expf(gi - gc[vi * 64 + j]); qv[sI] = valid ? QK[i * 65 + j] * e : 0.f; }
                unsigned char* bb = wsb + G_BLOBB + (size_t)(c * 128 + dir * 64 + 2 * kh + (vi >> 1)) * BLOBB_SZ;
                *(bf16x8*)(bb + 16384 + (f * 64 + ln) * 16) = pack8(qv[0], qv[1], qv[2], qv[3], qv[4], qv[5], qv[6], qv[7]);
            }
            if (tid_ < 256) { const int vi = tid_ >> 6, i = tid_ & 63; const float gl = gc[768 + vi], gi = gc[vi * 64 + i];
                float* sc = (float*)(wsb + G_BLOBB + (size_t)(c * 128 + (vi & 1) * 64 + 2 * kh + (vi >> 1)) * BLOBB_SZ + 24576);
                sc[i] = __expf(gi); sc[64 + i] = __expf(gl - gi); if (i == 0) sc[128] = __expf(gl); }
            __syncthreads();
            LAS float* AM = (LAS float*)(L + O_AM);
#pragma unroll
            for (int k = 0; k < 32; ++k) {
                const int n = tid_ + 512 * k, vi = n >> 12, dir = vi & 1, m = (n >> 6) & 63, i = n & 63;
                AM[vi * 4096 + (dir ? m * 64 + i : (63 - m) * 64 + (63 - i))] = -aval[k];
            }
        }
        __syncthreads();
        if (wv < 4) {
            const int dir = wv & 1, vhl = wv >> 1, vh = 2 * kh + vhl;
            const LAS float* AM = (const LAS float*)(L + O_AM) + wv * 4096;
            f32x2 x2[32];
#pragma unroll
            for (int q = 0; q < 32; ++q) x2[q] = (f32x2){0.f, 0.f};
            const int tgt = dir ? lane : 63 - lane;
            f32x4 rowA[8];
#define PRE_ROW_LOAD(dst, i_, c0_) do { _Pragma("unroll") for (int q_ = 0; q_ < 8; ++q_) if ((c0_) + 4 * q_ < (i_)) dst[q_] = *(const LAS f32x4*)(AM + (i_) * 64 + (c0_) + 4 * q_); } while (0)
#define PRE_ROW_FMA(src, i_, c0_) do { _Pragma("unroll") for (int q_ = 0; q_ < 8; ++q_) { const int m_ = (c0_) + 4 * q_; if (m_ < (i_)) { \
                const f32x2 c01_ = {src[q_][0], src[q_][1]}, c23_ = {src[q_][2], src[q_][3]}; a01 = __builtin_elementwise_fma(c01_, x2[m_ >> 1], a01); a23 = __builtin_elementwise_fma(c23_, x2[(m_ >> 1) + 1], a23); } } } while (0)
#pragma clang loop unroll(full)
            for (int i = 0; i < 64; ++i) {
                int tg = tgt; asm volatile("" : "+v"(tg));
                f32x2 a01 = {(i == tg) ? 1.f : 0.f, 0.f}, a23 = {0.f, 0.f};
                if (i > 0) {
                    PRE_ROW_LOAD(rowA, i, 0);
                    __builtin_amdgcn_sched_barrier(0);
                    PRE_ROW_FMA(rowA, i, 0);
                    if (i > 32) {
                        __builtin_amdgcn_sched_barrier(0);
                        PRE_ROW_LOAD(rowA, i, 32);
                        __builtin_amdgcn_sched_barrier(0);
                        PRE_ROW_FMA(rowA, i, 32);
                    }
                }
                x2[i >> 1][i & 1] = (a01[0] + a01[1]) + (a23[0] + a23[1]);
                __builtin_amdgcn_sched_barrier(0);
            }
#undef PRE_ROW_LOAD
#undef PRE_ROW_FMA
#define x(r_) x2[(r_) >> 1][(r_) & 1]
            bf16x8 tp1[2][4], tp2[2][4];
            const LAS float* sb = gc + 256 + wv * 64; const LAS float* se = gc + 512 + wv * 64;
#pragma unroll
            for (int tb = 0; tb < 4; ++tb) {
                float b_[16], e_[16];
#pragma unroll
                for (int q = 0; q < 4; ++q) { const f32x4 bv = *(const LAS f32x4*)(sb + 16 * tb + 4 * q), ev = *(const LAS f32x4*)(se + 16 * tb + 4 * q);
                    b_[4 * q] = bv[0]; b_[4 * q + 1] = bv[1]; b_[4 * q + 2] = bv[2]; b_[4 * q + 3] = bv[3]; e_[4 * q] = ev[0]; e_[4 * q + 1] = ev[1]; e_[4 * q + 2] = ev[2]; e_[4 * q + 3] = ev[3]; }
                float t0[8], t1[8];
#pragma unroll
                for (int sI = 0; sI < 8; ++sI) { t0[sI] = dir ? x(16 * tb + unperm(0, sI)) : x(63 - (16 * tb + unperm(0, sI))); t1[sI] = dir ? x(16 * tb + unperm(1, sI)) : x(63 - (16 * tb + unperm(1, sI))); }
                u32x4 P1, Q1, P2, Q2;
#define PRE_PK(T, SC, H) (u32x4){cvt_pk_bf16(T[0] * SC[unperm(H, 0)], T[1] * SC[unperm(H, 1)]), cvt_pk_bf16(T[2] * SC[unperm(H, 2)], T[3] * SC[unperm(H, 3)]), \
                                  cvt_pk_bf16(T[4] * SC[unperm(H, 4)], T[5] * SC[unperm(H, 5)]), cvt_pk_bf16(T[6] * SC[unperm(H, 6)], T[7] * SC[unperm(H, 7)])}
                P1 = PRE_PK(t0, b_, 0); Q1 = PRE_PK(t1, b_, 1); P2 = PRE_PK(t0, e_, 0); Q2 = PRE_PK(t1, e_, 1);
#undef PRE_PK
                u32x4 f0, f1, g0, g1;
#pragma unroll
                for (int w_ = 0; w_ < 4; ++w_) { auto r1 = __builtin_amdgcn_permlane32_swap(P1[w_], Q1[w_], false, false); f0[w_] = r1[0]; f1[w_] = r1[1];
                    auto r2 = __builtin_amdgcn_permlane32_swap(P2[w_], Q2[w_], false, false); g0[w_] = r2[0]; g1[w_] = r2[1]; }
                tp1[0][tb] = *reinterpret_cast<bf16x8*>(&f0); tp1[1][tb] = *reinterpret_cast<bf16x8*>(&f1);
                tp2[0][tb] = *reinterpret_cast<bf16x8*>(&g0); tp2[1][tb] = *reinterpret_cast<bf16x8*>(&g1);
            }
#undef x
            __builtin_amdgcn_sched_barrier(0);
            unsigned char* ufb = wsb + G_UF + (size_t)(c * 128 + dir * 64 + vh) * UF_SZ;
#pragma unroll
            for (int ib = 0; ib < 2; ++ib)
#pragma unroll
                for (int eb = 0; eb < 4; ++eb) {
                    f32x16 acc = {};
#pragma unroll
                    for (int tb = 0; tb < 4; ++tb) acc = MFMA32(tp1[ib][tb], *(const LAS bf16x8*)(L + O_VT + vhl * 18432 + (32 * eb + r32) * 144 + (16 * tb + 8 * hi) * 2), acc);
                    unsigned char* uf = ufb + ((eb * 2 + ib) * 64 + lane) * 32;
                    *(bf16x8*)uf = pack8(acc[0], acc[1], acc[2], acc[3], acc[4], acc[5], acc[6], acc[7]);
                    *(bf16x8*)(uf + 16) = pack8(acc[8], acc[9], acc[10], acc[11], acc[12], acc[13], acc[14], acc[15]);
                }
            __builtin_amdgcn_sched_barrier(0);
            unsigned char* wf = wsb + G_BLOBB + (size_t)(c * 128 + dir * 64 + vh) * BLOBB_SZ;
#pragma unroll
            for (int db = 0; db < 4; ++db)
#pragma unroll
                for (int ib = 0; ib < 2; ++ib) {
                    f32x16 acc = {};
#pragma unroll
                    for (int tb = 0; tb < 4; ++tb) acc = MFMA32(*(const LAS bf16x8*)(L + O_KT + (32 * db + r32) * 144 + (16 * tb + 8 * hi) * 2), tp2[ib][tb], acc);
                    *(bf16x8*)(wf + ((ib * 8 + 2 * db) * 64 + lane) * 16) = pack8(acc[0], acc[1], acc[2], acc[3], acc[4], acc[5], acc[6], acc[7]);
                    *(bf16x8*)(wf + ((ib * 8 + 2 * db + 1) * 64 + lane) * 16) = pack8(acc[8], acc[9], acc[10], acc[11], acc[12], acc[13], acc[14], acc[15]);
                }
        } else {
#pragma unroll
            for (int q = 0; q < 4; ++q) { const int f = (wv - 4) * 4 + q, db = f >> 2, tb = f & 3;
                const bf16x8 kf = *(const LAS bf16x8*)(L + O_KT + (32 * db + r32) * 144 + (16 * tb + 8 * hi) * 2);
                *(bf16x8*)(blobA + 16384 + (f * 64 + lane) * 16) = kf; }
        }
        __syncthreads();
    }
}

__device__ __forceinline__ void ph_gdn_scan2(const Ctx& C) {
    constexpr int NS = 132, BUF = 58368;
    bf16_t* go = (bf16_t*)(C.ws + G_O);
    LAS unsigned char* L = C.lds;
    const int lane = C.lane, r32 = lane & 31, hi = lane >> 5, wv = C.wave;
    for (int u = C.bid; u < 128; u += C.G) {
        const int x = u & 7, t = u >> 3, kh = x * 4 + (t >> 2), mem = t & 3, vh = 2 * kh + (mem & 1), dir = mem >> 1;
        const int v = dir * 64 + vh, eb = wv & 3;
#define SC2_CHUNK(s) (dir == 0 ? (s) : ((s) < 4 ? 3 - (s) : 135 - (s)))
#define SC2_DMA(s, bufi) do { if (wv >= 4) { const int c_ = SC2_CHUNK(s); const int ht_ = C.tid - 256; \
        const unsigned char* ga_ = C.ws + G_BLOBA + (size_t)(c_ * 32 + kh) * BLOBA_SZ; const unsigned char* gb_ = C.ws + G_BLOBB + (size_t)(c_ * 128 + v) * BLOBB_SZ; \
        LAS unsigned char* lb_ = L + (bufi) * BUF + (wv - 4) * 1024; \
        _Pragma("unroll") for (int k_ = 0; k_ < 8; ++k_) __builtin_amdgcn_global_load_lds((const unsigned*)(ga_ + (ht_ + 256 * k_) * 16), (LAS unsigned*)(lb_ + k_ * 4096), 16, 0, 0); \
        _Pragma("unroll") for (int k_ = 0; k_ < 6; ++k_) __builtin_amdgcn_global_load_lds((const unsigned*)(gb_ + (ht_ + 256 * k_) * 16), (LAS unsigned*)(lb_ + 32768 + k_ * 4096), 16, 0, 0); \
        if (ht_ < 64) __builtin_amdgcn_global_load_lds((const unsigned*)(gb_ + (ht_ + 1536) * 16), (LAS unsigned*)(lb_ + 32768 + 24576), 16, 0, 0); } } while (0)
        f32x16 S[4]; bf16x8 Sb[8];
#pragma unroll
        for (int i = 0; i < 4; ++i) S[i] = f32x16{};
#pragma unroll
        for (int i = 0; i < 8; ++i) Sb[i] = bf16x8{};
        __syncthreads();
        SC2_DMA(0, 0);
        u32x4 uraw[2][2], unext[2][2];
#define SC2_ULOAD(dst, s) do { const unsigned char* uf_ = C.ws + G_UF + (size_t)(SC2_CHUNK(s) * 128 + v) * UF_SZ + (eb * 2 * 64 + lane) * 32; \
        _Pragma("unroll") for (int ib_ = 0; ib_ < 2; ++ib_) { dst[ib_][0] = *(const u32x4*)(uf_ + ib_ * 2048); dst[ib_][1] = *(const u32x4*)(uf_ + ib_ * 2048 + 16); } } while (0)
        if (wv >= 4) {
            for (int s = 0; s < NS; ++s) {
                asm volatile("s_waitcnt vmcnt(0)" ::: "memory");
                __syncthreads();
                if (s + 1 < NS) SC2_DMA(s + 1, (s + 1) & 1);
            }
        } else {
        SC2_ULOAD(unext, 0);
        for (int s = 0; s < NS; ++s) {
            __syncthreads();
            const int c = SC2_CHUNK(s);
            {
#pragma unroll
                for (int ib = 0; ib < 2; ++ib) { uraw[ib][0] = unext[ib][0]; uraw[ib][1] = unext[ib][1]; }
                if (s + 1 < NS) SC2_ULOAD(unext, s + 1);
            }
            {
                const LAS unsigned char* B = L + (s & 1) * BUF;
                const LAS unsigned char* fQ = B + lane * 16; const LAS unsigned char* fK = B + 16384 + lane * 16;
                const LAS unsigned char* fW = B + 32768 + lane * 16; const LAS unsigned char* fD = B + 49152 + lane * 16;
                const LAS float* sc = (const LAS float*)(B + 57344);
                f32x16 ao[2], av[2];
#pragma unroll
                for (int ib = 0; ib < 2; ++ib) { ao[ib] = f32x16{};
#pragma unroll
                    for (int kb = 0; kb < 8; ++kb) ao[ib] = MFMA32(*(const LAS bf16x8*)(fQ + (ib * 8 + kb) * 1024), Sb[kb], ao[ib]); }
#pragma unroll
                for (int ib = 0; ib < 2; ++ib) {
#pragma unroll
                    for (int w2 = 0; w2 < 2; ++w2) { const u32x4 uw = uraw[ib][w2];
                        av[ib][8 * w2 + 0] = bf_lo(uw.x); av[ib][8 * w2 + 1] = bf_hi(uw.x); av[ib][8 * w2 + 2] = bf_lo(uw.y); av[ib][8 * w2 + 3] = bf_hi(uw.y);
                        av[ib][8 * w2 + 4] = bf_lo(uw.z); av[ib][8 * w2 + 5] = bf_hi(uw.z); av[ib][8 * w2 + 6] = bf_lo(uw.w); av[ib][8 * w2 + 7] = bf_hi(uw.w); }
#pragma unroll
                    for (int kb = 0; kb < 8; ++kb) av[ib] = MFMA32(*(const LAS bf16x8*)(fW + (ib * 8 + kb) * 1024), Sb[kb], av[ib]); }
                bf16x8 vb[4], vb2[4];
#pragma unroll
                for (int ib = 0; ib < 2; ++ib)
#pragma unroll
                    for (int h = 0; h < 2; ++h) {
                        const f32x4 d0 = *(const LAS f32x4*)(sc + 64 + 32 * ib + 16 * h + 4 * hi), d1 = *(const LAS f32x4*)(sc + 64 + 32 * ib + 16 * h + 8 + 4 * hi);
                        const f32x4 e0 = *(const LAS f32x4*)(sc + 32 * ib + 16 * h + 4 * hi), e1 = *(const LAS f32x4*)(sc + 32 * ib + 16 * h + 8 + 4 * hi);
                        const int r0 = 8 * h;
                        vb[2 * ib + h] = pack8(av[ib][r0], av[ib][r0 + 1], av[ib][r0 + 2], av[ib][r0 + 3], av[ib][r0 + 4], av[ib][r0 + 5], av[ib][r0 + 6], av[ib][r0 + 7]);
                        vb2[2 * ib + h] = pack8(av[ib][r0] * d0[0], av[ib][r0 + 1] * d0[1], av[ib][r0 + 2] * d0[2], av[ib][r0 + 3] * d0[3],
                                                av[ib][r0 + 4] * d1[0], av[ib][r0 + 5] * d1[1], av[ib][r0 + 6] * d1[2], av[ib][r0 + 7] * d1[3]);
#pragma unroll
                        for (int q = 0; q < 4; ++q) { ao[ib][r0 + q] *= e0[q]; ao[ib][r0 + 4 + q] *= e1[q]; }
                    }
#pragma unroll
                for (int ib = 0; ib < 2; ++ib) {
#pragma unroll
                    for (int tb = 0; tb < 4; ++tb) ao[ib] = MFMA32(*(const LAS bf16x8*)(fD + (ib * 4 + tb) * 1024), vb[tb], ao[ib]);
                    const unsigned ooff = (unsigned)(((dir * TR + c * 64 + 32 * ib + 4 * hi) * 8192 + vh * 128 + 32 * eb + r32));
#pragma unroll
                    for (int r = 0; r < 16; ++r) *(bf16_t*)((unsigned char*)go + (2u * ooff + (unsigned)(((r & 3) + 8 * (r >> 2)) * 16384))) = f2bf(ao[ib][r]);
                }
                const float gl = sc[128];
#pragma unroll
                for (int db = 0; db < 4; ++db) {
#pragma unroll
                    for (int r = 0; r < 16; ++r) S[db][r] *= gl;
#pragma unroll
                    for (int tb = 0; tb < 4; ++tb) S[db] = MFMA32(*(const LAS bf16x8*)(fK + (db * 4 + tb) * 1024), vb2[tb], S[db]);
                    Sb[2 * db] = pack8(S[db][0], S[db][1], S[db][2], S[db][3], S[db][4], S[db][5], S[db][6], S[db][7]);
                    Sb[2 * db + 1] = pack8(S[db][8], S[db][9], S[db][10], S[db][11], S[db][12], S[db][13], S[db][14], S[db][15]);
                }
            }
        }
        }
        asm volatile("s_waitcnt vmcnt(0)" ::: "memory");
        __syncthreads();
#undef SC2_CHUNK
#undef SC2_DMA
#undef SC2_ULOAD
    }
}

__device__ __forceinline__ void ph_gdn_post(const Ctx& C, const Params& p) {
    const bf16_t* go = (const bf16_t*)(C.ws + G_O); const bf16_t* z = (const bf16_t*)(C.ws + G_Z); bf16_t* og = (bf16_t*)(C.ws + G_OG);
    const int sub = C.lane >> 4, c8 = (C.lane & 15) * 8;
    const f32x4 g0 = *(const f32x4*)(p.in[18] + c8), g1 = *(const f32x4*)(p.in[18] + c8 + 4);
    constexpr int K = 4;
    for (int idx0 = (C.bid * 8 + C.wave) * (4 * K); idx0 < TR * 64; idx0 += C.G * 8 * 4 * K) {
        u32x4 a[K], b[K], zz[K]; float o[K][8], ss[K];
#pragma unroll
        for (int k = 0; k < K; ++k) { const size_t off = (size_t)(idx0 + 4 * k + sub) * 128 + c8;
            a[k] = *(const u32x4*)(go + off); b[k] = *(const u32x4*)(go + (size_t)TR * 8192 + off); zz[k] = *(const u32x4*)(z + off); }
#pragma unroll
        for (int k = 0; k < K; ++k) {
            o[k][0] = bf_lo(a[k].x) + bf_lo(b[k].x); o[k][1] = bf_hi(a[k].x) + bf_hi(b[k].x); o[k][2] = bf_lo(a[k].y) + bf_lo(b[k].y); o[k][3] = bf_hi(a[k].y) + bf_hi(b[k].y);
            o[k][4] = bf_lo(a[k].z) + bf_lo(b[k].z); o[k][5] = bf_hi(a[k].z) + bf_hi(b[k].z); o[k][6] = bf_lo(a[k].w) + bf_lo(b[k].w); o[k][7] = bf_hi(a[k].w) + bf_hi(b[k].w);
            float t = 0.f;
#pragma unroll
            for (int j = 0; j < 8; ++j) t += o[k][j] * o[k][j];
            ss[k] = t; }
#pragma unroll
        for (int sh = 8; sh >= 1; sh >>= 1)
#pragma unroll
            for (int k = 0; k < K; ++k) ss[k] += __shfl_xor(ss[k], sh);
#pragma unroll
        for (int k = 0; k < K; ++k) { const float rs = rsqrtf(ss[k] * (1.f / 128.f) + EPS);
            u32x4 w;
            w.x = cvt_pk_bf16(o[k][0] * rs * g0[0] * silu_f(bf_lo(zz[k].x)), o[k][1] * rs * g0[1] * silu_f(bf_hi(zz[k].x)));
            w.y = cvt_pk_bf16(o[k][2] * rs * g0[2] * silu_f(bf_lo(zz[k].y)), o[k][3] * rs * g0[3] * silu_f(bf_hi(zz[k].y)));
            w.z = cvt_pk_bf16(o[k][4] * rs * g1[0] * silu_f(bf_lo(zz[k].z)), o[k][5] * rs * g1[1] * silu_f(bf_hi(zz[k].z)));
            w.w = cvt_pk_bf16(o[k][6] * rs * g1[2] * silu_f(bf_lo(zz[k].w)), o[k][7] * rs * g1[3] * silu_f(bf_hi(zz[k].w)));
            *(u32x4*)(og + (size_t)(idx0 + 4 * k + sub) * 128 + c8) = w; }
    }
}

template <int R>
__device__ __forceinline__ void pool_window_block(const bf16_t* __restrict__ u, bf16_t* __restrict__ m, int t0, int c) {
    const int slo = t0 < NCTX ? 0 : NCTX, shi = t0 < NCTX ? NCTX : TR;
    f32x4 rowv[16 + 2 * R];
    { u32x2 rw[16 + 2 * R];
#pragma unroll
      for (int i = 0; i < 16 + 2 * R; ++i) { const int r = t0 - R + i; rw[i] = (r >= slo && r < shi) ? *(const u32x2*)(u + (size_t)r * DM + c) : (u32x2){0u, 0u}; }
#pragma unroll
      for (int i = 0; i < 16 + 2 * R; ++i) rowv[i] = (f32x4){bf_lo(rw[i].x), bf_hi(rw[i].x), bf_lo(rw[i].y), bf_hi(rw[i].y)}; }
#pragma unroll
    for (int j = 0; j < 16; ++j) {
        const int t = t0 + j, lo = (t - R) > slo ? (t - R) : slo, hi = (t + R + 1) < shi ? (t + R + 1) : shi;
        f32x4 sum = rowv[j];
#pragma unroll
        for (int k = 1; k < 2 * R + 1; ++k) sum += rowv[j + k];
        const f32x4 v = sum * (1.f / (float)(hi - lo)) - rowv[j + R];
        u32x2 w; w.x = cvt_pk_bf16(v[0], v[1]); w.y = cvt_pk_bf16(v[2], v[3]);
        *(u32x2*)(m + (size_t)t * DM + c) = w;
    }
}
__device__ __forceinline__ void ph_pool_window(const Ctx& C) {
    const bf16_t* u = (const bf16_t*)(C.ws + P_U); bf16_t* m = (bf16_t*)(C.ws + P_M);
    constexpr int total = (TR / 16) * 1024;
    const int per = C.G * 512, nfull = total / per;
    for (int it = 0; it <= nfull; ++it) {
        int idx;
        if (it < nfull) idx = it * per + C.bid * 512 + C.tid;
        else {
            const int j = C.bid;
            const int nl = (total - nfull * per) / 64;
            const int jj = j + C.G * ((C.wave - C.bid) & 7);
            if (jj >= nl) break;
            idx = nfull * per + jj * 64 + C.lane;
        }
        const int t0 = (idx >> 10) * 16, c4 = idx & 1023, c = c4 * 4, g = c4 >> 8;
        if (g == 0) pool_window_block<1>(u, m, t0, c);
        else if (g == 1) pool_window_block<2>(u, m, t0, c);
        else if (g == 2) pool_window_block<4>(u, m, t0, c);
        else pool_window_block<8>(u, m, t0, c);
    }
}

constexpr int N_PHASES = 2 + 6 + 6 + 5 + 6;
#ifndef SITE_MASK
#define SITE_MASK 0xffffffffu
#endif
#ifndef REPEAT_MASK
#define REPEAT_MASK 0u
#endif
#define PH_ON(k) (((SITE_MASK >> ((k) & 31)) & 1u) && lo <= (k) && (k) < hi)
#define PH_REP(k) ((((REPEAT_MASK) >> ((k) & 31)) & 1u) != 0u)
#define PHASE(k, ...) if (PH_ON(k)) { C.tid = tid_opaque(C.wave); C.lane = C.tid & 63; { size_t z_ = 0; asm volatile("" : "+s"(z_)); C.ws = p.ws + z_; } ws = C.ws; __VA_ARGS__ } if (PH_REP(k)) { if (PH_ON(k)) { __VA_ARGS__ } } if (lo <= (k) && (k) + 1 < hi) xcd_barrier(bar);

using SegY = pg8::SegCfg<WS_Y, 4096, 0>;

template <int IT, int PH0>
__device__ __forceinline__ void mla_layer(Ctx& C, const Params& p, const int lo, const int hi, const XcdBarrier& bar, char* lds_generic) {
    unsigned char* ws = C.ws;
    PHASE(PH0 + 0,
        using G = pg8::GC<WS_H, WS_W_MLA_IN + IT * SZ_W_MLA_IN, MLA_NP, 4096, 4096, 4096, 0>;
        using SG = pg8::SegCfg<A_CQ, 1024, 0, 4, A_CKV, 512, 0, 6, A_Z, 4096, 0, 22, A_KRRAW, 256, 1>;
        pg8::EpiStore<SG, false> E{ws, nullptr};
        pg8::gemm_phase<G>(C.lds, ws, C.G, C.bid, E, C.wave);
    )
    PHASE(PH0 + 1, ph_mla_stats(C); )
    PHASE(PH0 + 2,
        { using G = pg8::GC<A_CQ, WS_W_QUP + IT * SZ_W_QUP, 6144, 1024, 1024, 1024, 0, IT>;
          pg8::EpiStore<pg8::SegCfg<A_Q, 6144, 0>, true> E{ws, (const float*)(ws + A_RSQ)};
          pg8::gemm_phase<G>(C.lds, ws, C.G, C.bid, E, C.wave); }
        { using G = pg8::GC<A_CKV, WS_W_KVUP + IT * SZ_W_KVUP, 8192, 512, 512, 512, 0>;
          pg8::EpiStore<pg8::SegCfg<A_KV, 8192, 0>, true> E{ws, (const float*)(ws + A_RSKV)};
          pg8::gemm_phase<G>(C.lds, ws, C.G, C.G == 256 ? (C.bid ^ 128) : C.bid, E, C.wave); }
    )
    PHASE(PH0 + 3, ph_mla_attn<IT>(C, lds_generic); )
    PHASE(PH0 + 4,
        using G = pg8::GC<A_OG, WS_W_MLA_OUT + IT * SZ_W_MLA_OUT, 4096, 4096, 4096, 4096, 0, 1>;
        pg8::EpiStore<SegY, false> E{ws, nullptr};
        pg8::gemm_phase<G>(C.lds, ws, C.G, C.bid, E, C.wave);
        if (IT == 0) {
            using G2 = pg8::GC<A_OG, WS_W_MLA_OUT + IT * SZ_W_MLA_OUT, 4096, 4096, 4096, 4096, 0, 0, 1, YPARTS>;
            pg8::EpiPart<YPARTS, 4096> E2{(float*)(ws + WS_YPART)};
            pg8::gemm_phase<G2>(C.lds, ws, C.G, C.bid, E2, C.wave); }
    )
    PHASE(PH0 + 5, if (IT == 0) ph_rows<1>(C, p, 0, 1); else ph_rows<2>(C, p, 3, 3); )
}

__global__ void __launch_bounds__(512, 2) mega(Params p) {
    extern __shared__ __attribute__((aligned(16))) unsigned char shm[];
    Ctx C; C.wave = __builtin_amdgcn_readfirstlane(threadIdx.x >> 6); C.tid = tid_opaque(C.wave); C.lane = C.tid & 63; C.bid = blockIdx.x; C.G = gridDim.x;
    C.ws = p.ws; C.lds = (LAS unsigned char*)shm;
    volatile LAS unsigned* misc = (volatile LAS unsigned*)(C.lds + LDS_STAGE);
    if (C.tid < 4) misc[C.tid] = 0u;
    __syncthreads();
    const int lo = p.ph_lo, hi = p.ph_hi;
    XcdBarrier bar; bar.bar = (unsigned*)(p.ws + WS_BAR); bar.x = 0; bar.st = misc; bar.w = (unsigned)C.wave;
    if (hi - lo > 1) bar = xcd_barrier_post((unsigned*)(p.ws + WS_BAR), misc, (unsigned)C.wave);
    unsigned char* ws = p.ws;

    PHASE(0, ph_adaln(C, p, 0, C.G == 256 ? 144 : 192, 0); ph_wconv<0>(C, p, 0, p.ntiles_early); ph_rope_table(C); )
    PHASE(1, ph_rows<0>(C, p, 0, 0); )
    mla_layer<0, 2>(C, p, lo, hi, bar, (char*)shm);
    PHASE(8,
        using G = pg8::GC<WS_H, WS_W_GDN_IN, GDN_IN, 4096, 4096, 4096, 0, 0, TR / 256, 0, 1>;
        using SG = pg8::SegCfg<G_QKV, 16384, 0, 64, G_AB, 256, 1, 65, G_Z, 8192, 0>;
        pg8::EpiStore<SG, false, true> E{ws, nullptr};
        pg8::gemm_phase<G>(C.lds, ws, C.G, C.bid, E, C.wave);
        if (C.G == 256) { C.tid = tid_opaque(C.wave); C.lane = C.tid & 63; ph_wconv<2>(C, p, p.ntiles_early, p.ntiles_early + p.pad_); }
    )
    PHASE(9, ph_gdn_pre(C, p); )
    PHASE(10, ph_gdn_scan2(C); C.tid = tid_opaque(C.wave); C.lane = C.tid & 63; if (C.G == 256) ph_adaln(C, p, 144, 192, 128); ph_wconv<1>(C, p, p.ntiles_early + (C.G == 256 ? p.pad_ : 0), C.G == 256 ? p.ntiles_l3 : p.ntiles); )
    PHASE(11, ph_gdn_post(C, p); )
    PHASE(12,
        using G = pg8::GC<G_OG, WS_W_GDN_OUT, 4096, 8192, 8192, 8192, 0, 1>;
        pg8::EpiStore<SegY, false> E{ws, nullptr};
        pg8::gemm_phase<G>(C.lds, ws, C.G, C.bid, E, C.wave);
        using G2 = pg8::GC<G_OG, WS_W_GDN_OUT, 4096, 8192, 8192, 8192, 0, 0, 1, YPARTS>;
        pg8::EpiPart<YPARTS, 4096> E2{(float*)(ws + WS_YPART)};
        pg8::gemm_phase<G2>(C.lds, ws, C.G, C.bid, E2, C.wave);
    )
    PHASE(13, ph_rows<1>(C, p, 1, 2); )
    PHASE(14,
        using G = pg8::GC<WS_H, WS_W_POOL_IN, 8192, 4096, 4096, 4096, 0>;
        using SG = pg8::SegCfg<P_U, 4096, 0, 16, P_Z, 4096, 0>;
        pg8::EpiStore<SG, false> E{ws, nullptr};
        pg8::gemm_phase<G>(C.lds, ws, C.G, C.bid, E, C.wave);
        if (C.G == 256) { C.tid = tid_opaque(C.wave); C.lane = C.tid & 63; ph_wconv<3>(C, p, p.ntiles_l3, p.ntiles); }
    )
    PHASE(15, ph_pool_window(C); )
    PHASE(16,
        using G = pg8::GC<P_M, WS_W_POOL_GRP, 4096, 1024, 4096, 1024, 4>;
        pg8::EpiPool E{(bf16_t*)(ws + P_G), (const bf16_t*)(ws + P_Z), p.in[22], 4096};
        pg8::gemm_phase<G>(C.lds, ws, C.G, C.bid, E, C.wave);
    )
    PHASE(17,
        using G = pg8::GC<P_G, WS_W_POOL_OUT, 4096, 4096, 4096, 4096, 0, 1>;
        pg8::EpiStore<SegY, false> E{ws, nullptr};
        pg8::gemm_phase<G>(C.lds, ws, C.G, C.bid, E, C.wave);
        using G2 = pg8::GC<P_G, WS_W_POOL_OUT, 4096, 4096, 4096, 4096, 0, 0, 1, YPARTS>;
        pg8::EpiPart<YPARTS, 4096> E2{(float*)(ws + WS_YPART)};
        pg8::gemm_phase<G2>(C.lds, ws, C.G, C.bid, E2, C.wave);
    )
    PHASE(18, ph_rows<1>(C, p, 2, 3); )
    mla_layer<1, 19>(C, p, lo, hi, bar, (char*)shm);
}

static int add_job(Params& p, int& nj, int& tiles, const float* src, const float* scale, bf16_t* dst, int ld_src, int K, int ncols) {
    TJob& j = p.jobs[nj++]; j.src = src; j.scale = scale; j.dst = dst; j.ld_src = ld_src; j.K = K; j.ncols = ncols; j.tile0 = tiles;
    tiles += (ncols / 64) * (K / 128); return nj;
}

extern "C" void kernel_launch(void* const* d_in, const int* in_sizes, int n_in, void* d_out, int out_size, void* d_ws, size_t ws_size, hipStream_t stream) {
    static int grid = 0;
    if (grid == 0) {
        if (n_in != 24 || out_size != NLAT * DM || ws_size < WS_END) { fprintf(stderr, "kernel_launch: unexpected shapes (n_in %d out %d ws %zu need %zu)\n", n_in, out_size, ws_size, (size_t)WS_END); grid = -1; return; }
        int dev = 0, cus = 0, per_cu = 0;
        if (hipGetDevice(&dev) != hipSuccess || hipDeviceGetAttribute(&cus, hipDeviceAttributeMultiprocessorCount, dev) != hipSuccess) { grid = -1; return; }
        if (hipFuncSetAttribute((const void*)mega, hipFuncAttributeMaxDynamicSharedMemorySize, LDS_BYTES) != hipSuccess) { fprintf(stderr, "kernel_launch: hipFuncSetAttribute failed\n"); grid = -1; return; }
        if (hipOccupancyMaxActiveBlocksPerMultiprocessor(&per_cu, (const void*)mega, 512, LDS_BYTES) != hipSuccess || per_cu < 1) fprintf(stderr, "kernel_launch: occupancy query reports %d\n", per_cu);
        (void)hipGetLastError();
        grid = cus;
    }
    if (grid < 0) return;
    (void)hipMemsetAsync((char*)d_ws + WS_BAR, 0, 16384, stream);
    Params p{};
    for (int i = 0; i < 24; ++i) p.in[i] = (const float*)d_in[i];
    p.out = (float*)d_out; p.ws = (unsigned char*)d_ws;
    unsigned char* ws = (unsigned char*)d_ws;
    int nj = 0, tiles = 0;
    auto mla_jobs = [&](int j) {
        const float* win = p.in[8] + (size_t)j * 4096 * 5696; bf16_t* d = (bf16_t*)(ws + WS_W_MLA_IN + j * SZ_W_MLA_IN);
        add_job(p, nj, tiles, win, nullptr, d, 5696, 4096, 1536);
        add_job(p, nj, tiles, win + 1600, nullptr, d + (size_t)1536 * 4096, 5696, 4096, 4096);
        add_job(p, nj, tiles, win + 1536, nullptr, d + (size_t)5632 * 4096, 5696, 4096, 64);
        add_job(p, nj, tiles, nullptr, nullptr, d + (size_t)5696 * 4096, 5696, 4096, 192);
        add_job(p, nj, tiles, p.in[10] + (size_t)j * 1024 * 6144, p.in[9] + j * 1024, (bf16_t*)(ws + WS_W_QUP + j * SZ_W_QUP), 6144, 1024, 6144);
        add_job(p, nj, tiles, p.in[12] + (size_t)j * 512 * 8192, p.in[11] + j * 512, (bf16_t*)(ws + WS_W_KVUP + j * SZ_W_KVUP), 8192, 512, 8192);
        add_job(p, nj, tiles, p.in[13] + (size_t)j * 4096 * 4096, nullptr, (bf16_t*)(ws + WS_W_MLA_OUT + j * SZ_W_MLA_OUT), 4096, 4096, 4096);
    };
    mla_jobs(0);
    add_job(p, nj, tiles, p.in[14], nullptr, (bf16_t*)(ws + WS_W_GDN_IN), GDN_IN, 4096, GDN_IN);
    p.ntiles_early = tiles; const int tiles_early_ = tiles;
    add_job(p, nj, tiles, p.in[19], nullptr, (bf16_t*)(ws + WS_W_GDN_OUT), 4096, 8192, 4096);
    const int tiles_gout_ = tiles;
    add_job(p, nj, tiles, p.in[20], nullptr, (bf16_t*)(ws + WS_W_POOL_IN), 8192, 4096, 8192);
    for (int g = 0; g < 4; ++g) add_job(p, nj, tiles, p.in[21] + (size_t)g * 1024 * 1024, nullptr, (bf16_t*)(ws + WS_W_POOL_GRP) + (size_t)g * 1024 * 1024, 1024, 1024, 1024);
    add_job(p, nj, tiles, p.in[23], nullptr, (bf16_t*)(ws + WS_W_POOL_OUT), 4096, 4096, 4096);
    const int tiles_l3_ = tiles;
    mla_jobs(1);
    p.njobs = nj; p.ntiles = tiles; p.pad2_ = 0;
    p.pad_ = tiles_gout_ - tiles_early_;
    p.ntiles_l3 = tiles - 3808 > tiles_l3_ ? tiles - 3808 : tiles_l3_;
#if N_LAUNCHES == 1
    p.ph_lo = 0; p.ph_hi = N_PHASES;
    hipLaunchKernelGGL(mega, dim3(grid), dim3(512), LDS_BYTES, stream, p);
#else
    for (int k = 0; k < N_PHASES; ++k) { p.ph_lo = k; p.ph_hi = k + 1; hipLaunchKernelGGL(mega, dim3(grid), dim3(512), LDS_BYTES, stream, p); }
#endif
    const hipError_t le = hipPeekAtLastError();
    if (le != hipSuccess) fprintf(stderr, "kernel_launch: launch failed: %s\n", hipGetErrorName(le));
}
```
